# Optimizing an MI355X kernel written in HIP

```python
import math
import jax, jax.numpy as jnp
from jax import lax
import numpy as np

D_MODEL = 1024
BATCH = 8
SEQ = 4096
DEPTH = 2

N_MIXERS = 2
ROPE_THETA = 10000.0
NORM_EPS = 1e-6
Q_BLOCK = 128
D_FF = 2816
FFN_RESIDUAL_WEIGHT = 0.5

DIFF_HEADS = 8
DIFF_HEAD_DIM = D_MODEL // DIFF_HEADS // 2

MLA_HEADS = 8
MLA_NOPE = 128
MLA_ROPE = 64
MLA_V = 128
MLA_Q_RANK = 384
MLA_KV_RANK = 256

kernel_name = "hybrid_diffattn_mla_macaron"


def rmsnorm(x, gain):
    x32 = x.astype(jnp.float32)
    y = x32 * lax.rsqrt(jnp.mean(x32 * x32, axis=-1, keepdims=True) + NORM_EPS)
    return (y * gain.astype(jnp.float32)).astype(x.dtype)


def rope_tables(positions, dim):
    inv_freq = ROPE_THETA ** (-jnp.arange(0, dim, 2, dtype=jnp.float32) / dim)
    ang = positions.astype(jnp.float32)[..., None] * inv_freq
    return jnp.cos(ang), jnp.sin(ang)


def rope(x, cos, sin):
    shape = cos.shape[:2] + (1,) * (x.ndim - 3) + cos.shape[2:]
    c, s = cos.reshape(shape), sin.reshape(shape)
    x1, x2 = jnp.split(x.astype(jnp.float32), 2, axis=-1)
    return jnp.concatenate([x1 * c - x2 * s, x2 * c + x1 * s], axis=-1).astype(x.dtype)


def swiglu(h, w_gate, w_up, w_down):
    return (jax.nn.silu(h @ w_gate) * (h @ w_up)) @ w_down


def causal_softmax(scores, q_start, seq):
    q_pos = q_start + jnp.arange(Q_BLOCK)
    mask = jnp.arange(seq)[None, :] <= q_pos[:, None]
    return jax.nn.softmax(jnp.where(mask, scores, -jnp.inf), axis=-1)


def sweep_query_blocks(block_fn, q, seq):
    n_blocks = seq // Q_BLOCK
    def to_blocks(a):
        a = a.reshape((a.shape[0], n_blocks, Q_BLOCK) + a.shape[2:])
        return jnp.moveaxis(a, 1, 0)
    q_blocks = jax.tree_util.tree_map(to_blocks, q)
    starts = jnp.arange(n_blocks) * Q_BLOCK
    out = lax.map(lambda args: block_fn(args[0], args[1]), (q_blocks, starts))
    out = jnp.moveaxis(out, 0, 1)
    return out.reshape((out.shape[0], seq) + out.shape[3:])


def diff_attention(h, w_in, lq1, lk1, lq2, lk2, sub_gain, w_out, cos, sin, lambda_init):
    b, s, _ = h.shape
    q, k, v = jnp.split(h @ w_in, 3, axis=-1)
    q = rope(q.reshape(b, s, DIFF_HEADS, 2, DIFF_HEAD_DIM), cos, sin)
    k = rope(k.reshape(b, s, DIFF_HEADS, 2, DIFF_HEAD_DIM), cos, sin)
    v = v.reshape(b, s, DIFF_HEADS, 2 * DIFF_HEAD_DIM)
    f32 = jnp.float32
    lam = (jnp.exp(jnp.sum(lq1.astype(f32) * lk1.astype(f32)))
           - jnp.exp(jnp.sum(lq2.astype(f32) * lk2.astype(f32))) + lambda_init)
    scale = DIFF_HEAD_DIM ** -0.5

    def block(q_blk, start):
        sc = jnp.einsum('bqhcd,bkhcd->bhcqk', q_blk, k).astype(f32) * scale
        p = causal_softmax(sc, start, s)
        a = p[:, :, 0] - lam * p[:, :, 1]
        return jnp.einsum('bhqk,bkhe->bqhe', a.astype(v.dtype), v)

    o = sweep_query_blocks(block, q, s)
    o = rmsnorm(o, sub_gain) * (1.0 - lambda_init)
    return o.reshape(b, s, DIFF_HEADS * 2 * DIFF_HEAD_DIM) @ w_out


def mla_attention(h, w_in, q_norm, w_q_up, kv_norm, w_kv_up, w_out, cos, sin):
    b, s, _ = h.shape
    c = h @ w_in
    cq = c[..., :MLA_Q_RANK]
    ckv = c[..., MLA_Q_RANK:MLA_Q_RANK + MLA_KV_RANK]
    k_rope = rope(c[..., MLA_Q_RANK + MLA_KV_RANK:], cos, sin)
    q = (rmsnorm(cq, q_norm) @ w_q_up).reshape(b, s, MLA_HEADS, MLA_NOPE + MLA_ROPE)
    q_nope, q_rope = q[..., :MLA_NOPE], rope(q[..., MLA_NOPE:], cos, sin)
    kv = (rmsnorm(ckv, kv_norm) @ w_kv_up).reshape(b, s, MLA_HEADS, MLA_NOPE + MLA_V)
    k_nope, v = kv[..., :MLA_NOPE], kv[..., MLA_NOPE:]
    scale = (MLA_NOPE + MLA_ROPE) ** -0.5

    def block(q_blk, start):
        qn, qr = q_blk
        sc = (jnp.einsum('bqhd,bkhd->bhqk', qn, k_nope)
              + jnp.einsum('bqhr,bkr->bhqk', qr, k_rope)).astype(jnp.float32) * scale
        p = causal_softmax(sc, start, s)
        return jnp.einsum('bhqk,bkhd->bqhd', p.astype(v.dtype), v)

    o = sweep_query_blocks(block, (q_nope, q_rope), s)
    return o.reshape(b, s, MLA_HEADS * MLA_V) @ w_out


def setup_inputs(seed: int = 0) -> dict:
    key = jax.random.key(seed)
    ks = iter(jax.random.split(key, 40))
    n_diff = (DEPTH + 1) // 2
    n_mla = DEPTH // 2

    def w(shape, fan_in):
        return jax.random.normal(next(ks), shape, jnp.float32) * (fan_in ** -0.5)

    def gain(shape):
        return 1.0 + 0.02 * jax.random.normal(next(ks), shape, jnp.float32)

    x = jax.random.normal(next(ks), (BATCH, SEQ, D_MODEL), jnp.float32)
    offset = jax.random.randint(next(ks), (BATCH, 1), 0, 1024, dtype=jnp.int32)
    positions = offset + jnp.arange(SEQ, dtype=jnp.int32)[None, :]
    return {
        "x": x,
        "positions": positions,
        "ffn1_norm": gain((DEPTH, D_MODEL)),
        "ffn1_w_gate": w((DEPTH, D_MODEL, D_FF), D_MODEL),
        "ffn1_w_up": w((DEPTH, D_MODEL, D_FF), D_MODEL),
        "ffn1_w_down": w((DEPTH, D_FF, D_MODEL), D_FF),
        "mix_norm": gain((DEPTH, D_MODEL)),
        "ffn2_norm": gain((DEPTH, D_MODEL)),
        "ffn2_w_gate": w((DEPTH, D_MODEL, D_FF), D_MODEL),
        "ffn2_w_up": w((DEPTH, D_MODEL, D_FF), D_MODEL),
        "ffn2_w_down": w((DEPTH, D_FF, D_MODEL), D_FF),
        "diff_w_in": w((n_diff, D_MODEL, 3 * D_MODEL), D_MODEL),
        "diff_lambda_q1": 0.1 * jax.random.normal(next(ks), (n_diff, DIFF_HEAD_DIM), jnp.float32),
        "diff_lambda_k1": 0.1 * jax.random.normal(next(ks), (n_diff, DIFF_HEAD_DIM), jnp.float32),
        "diff_lambda_q2": 0.1 * jax.random.normal(next(ks), (n_diff, DIFF_HEAD_DIM), jnp.float32),
        "diff_lambda_k2": 0.1 * jax.random.normal(next(ks), (n_diff, DIFF_HEAD_DIM), jnp.float32),
        "diff_sub_norm": gain((n_diff, 2 * DIFF_HEAD_DIM)),
        "diff_w_out": w((n_diff, D_MODEL, D_MODEL), D_MODEL),
        "mla_w_in": w((n_mla, D_MODEL, MLA_Q_RANK + MLA_KV_RANK + MLA_ROPE), D_MODEL),
        "mla_q_norm": gain((n_mla, MLA_Q_RANK)),
        "mla_w_q_up": w((n_mla, MLA_Q_RANK, MLA_HEADS * (MLA_NOPE + MLA_ROPE)), MLA_Q_RANK),
        "mla_kv_norm": gain((n_mla, MLA_KV_RANK)),
        "mla_w_kv_up": w((n_mla, MLA_KV_RANK, MLA_HEADS * (MLA_NOPE + MLA_V)), MLA_KV_RANK),
        "mla_w_out": w((n_mla, MLA_HEADS * MLA_V, D_MODEL), MLA_HEADS * MLA_V),
        "final_norm": gain((D_MODEL,)),
    }


def reference(x, positions, ffn1_norm, ffn1_w_gate, ffn1_w_up, ffn1_w_down, mix_norm,
              ffn2_norm, ffn2_w_gate, ffn2_w_up, ffn2_w_down,
              diff_w_in, diff_lambda_q1, diff_lambda_k1, diff_lambda_q2, diff_lambda_k2,
              diff_sub_norm, diff_w_out,
              mla_w_in, mla_q_norm, mla_w_q_up, mla_kv_norm, mla_w_kv_up, mla_w_out,
              final_norm):
    cos_d, sin_d = rope_tables(positions, DIFF_HEAD_DIM)
    cos_m, sin_m = rope_tables(positions, MLA_ROPE)
    for i in range(DEPTH):
        x = x + FFN_RESIDUAL_WEIGHT * swiglu(rmsnorm(x, ffn1_norm[i]),
                                             ffn1_w_gate[i], ffn1_w_up[i], ffn1_w_down[i])
        h = rmsnorm(x, mix_norm[i])
        j = i // N_MIXERS
        if i % N_MIXERS == 0:
            lambda_init = 0.8 - 0.6 * math.exp(-0.3 * i)
            x = x + diff_attention(h, diff_w_in[j], diff_lambda_q1[j], diff_lambda_k1[j],
                                   diff_lambda_q2[j], diff_lambda_k2[j], diff_sub_norm[j],
                                   diff_w_out[j], cos_d, sin_d, lambda_init)
        else:
            x = x + mla_attention(h, mla_w_in[j], mla_q_norm[j], mla_w_q_up[j], mla_kv_norm[j],
                                  mla_w_kv_up[j], mla_w_out[j], cos_m, sin_m)
        x = x + FFN_RESIDUAL_WEIGHT * swiglu(rmsnorm(x, ffn2_norm[i]),
                                             ffn2_w_gate[i], ffn2_w_up[i], ffn2_w_down[i])
    return rmsnorm(x, final_norm)
```

```cpp
#include <hip/hip_runtime.h>
#include <hip/hip_cooperative_groups.h>
#include <cstdio>
#include <cstdint>
#include <cmath>
namespace cg = cooperative_groups;
namespace pg8 {
#define PG8_LAS __attribute__((address_space(3)))
typedef unsigned short bf16_t;
typedef short bf16x8 __attribute__((ext_vector_type(8)));
typedef float f32x4 __attribute__((ext_vector_type(4)));
typedef unsigned u32x4 __attribute__((ext_vector_type(4)));
constexpr int BM = 256, BK = 64, HALF = 128, HTB = HALF * BK * 2  , STAGE_BYTES = 8 * HTB, NXCD = 8, WGM = 8;

__host__ __device__ __forceinline__ int lds_byte(int r, int c) { const int st = (r >> 4) * 2 + (c >> 5), rr = r & 15, cc = c & 31, ob = rr * 64 + cc * 2; return st * 1024 + (ob ^ (((ob >> 9) & 1) << 5)); }
__host__ __device__ __forceinline__ void stage_rc(int b, int& R, int& C) { const int st = b / 1024, sb = b % 1024, swz = sb ^ (((sb >> 9) & 1) << 5); R = (st >> 1) * 16 + swz / 64; C = (st & 1) * 32 + (swz % 64) / 2; }
__host__ __device__ __forceinline__ int perm32(int rho) { const int n = rho >> 4, i = rho & 15; return 8 * (i >> 2) + 4 * n + (i & 3); }

struct Unit { int pm, pn; };
struct Gemm { const bf16_t* A; const bf16_t* Bt; int M, N, K; };

struct StaticOrder {
    int nM, nN, nwg, G, c;
    __host__ __device__ void init(int M, int N, int G_, int c_) { nM = M / BM; nN = N / BM; nwg = nM * nN; G = G_; c = c_; }
    __host__ __device__ bool next(int i, Unit& u) const {
        const long L = (long)i * G + c; if (L >= nwg) return false;
        int wgid = (int)L; { const int q = nwg / NXCD, r = nwg % NXCD, xcd = wgid % NXCD, off = wgid / NXCD; wgid = (xcd < r ? xcd * (q + 1) : r * (q + 1) + (xcd - r) * q) + off; }
        const int nig = WGM * nN, gid = wgid / nig, fm = gid * WGM, gsz = (nM - fm) < WGM ? (nM - fm) : WGM;
        u.pm = fm + ((wgid % nig) % gsz); u.pn = (wgid % nig) / gsz; return true;
    }
    __device__ __forceinline__ void a_ready(const Unit&) const {}
    __device__ __forceinline__ void done(const Unit&) const {}
};

__device__ __forceinline__ unsigned cvt_pk_bf16(float lo, float hi) { unsigned r; asm volatile("v_cvt_pk_bf16_f32 %0, %1, %2" : "=v"(r) : "v"(lo), "v"(hi)); return r; }
typedef float f32x2 __attribute__((ext_vector_type(2)));
constexpr float NORM_EPS = 1e-6f;
__device__ __forceinline__ float rstd1024(const float* ssq, int row) { const f32x4* p = (const f32x4*)(ssq + (size_t)row * 16); const f32x4 a = p[0], b = p[1], c = p[2], d = p[3];
    const float s = (((a[0] + a[1]) + (a[2] + a[3])) + ((b[0] + b[1]) + (b[2] + b[3]))) + (((c[0] + c[1]) + (c[2] + c[3])) + ((d[0] + d[1]) + (d[2] + d[3]))); return rsqrtf(s * (1.0f / 1024.0f) + NORM_EPS); }
__device__ __forceinline__ unsigned cvt2(float lo, float hi) { typedef float f2 __attribute__((ext_vector_type(2))); typedef __bf16 b2 __attribute__((ext_vector_type(2))); f2 v = {lo, hi}; b2 b = __builtin_convertvector(v, b2); return __builtin_bit_cast(unsigned, b); }
__device__ __forceinline__ u32x4 pack8(const f32x4 a, const f32x4 b) { u32x4 w; w.x = cvt2(a[0], a[1]); w.y = cvt2(a[2], a[3]); w.z = cvt2(b[0], b[1]); w.w = cvt2(b[2], b[3]); return w; }
__device__ __forceinline__ float silu_mul(float g, float u) { return g * __builtin_amdgcn_rcpf(1.0f + __builtin_amdgcn_exp2f(-1.4426950408889634f * g)) * u; }

struct EpiSwiglu {
    static constexpr bool PERM = true, AFTER_DRAIN = false;
    bf16_t* O; int ldo; const PG8_LAS float* rtab; mutable int ui;
    __device__ __forceinline__ void operator()(const f32x4 (&acc)[2][2][4][2], const Unit& u, int wr, int wc, int fr, int fq) const {
        const PG8_LAS float* rt = rtab + ui * 256 + wr * 64 + fr; ++ui;
        const int row0 = u.pm * BM + wr * 64 + fr; const int col0 = u.pn * HALF + wc * 32 + 8 * fq;
#pragma unroll
        for (int ai = 0; ai < 2; ++ai)
#pragma unroll
            for (int m = 0; m < 4; ++m) { const int row = row0 + ai * HALF + m * 16; const float r = rt[ai * HALF + m * 16]; const float r2 = -1.4426950408889634f * r, rr = r * r;
                f32x4 v[2];
#pragma unroll
                for (int n = 0; n < 2; ++n)
#pragma unroll
                    for (int j = 0; j < 4; ++j) { const float g = acc[ai][0][m][n][j], uu = acc[ai][1][m][n][j]; v[n][j] = (g * uu) * (rr * __builtin_amdgcn_rcpf(1.0f + __builtin_amdgcn_exp2f(g * r2))); }
                *(u32x4*)(O + (size_t)row * ldo + col0) = pack8(v[0], v[1]); }
    }
};

struct EpiResid {
    static constexpr bool PERM = true, AFTER_DRAIN = false;
    bf16_t* xb; float* ssq; float scale;
    __device__ __forceinline__ void operator()(const f32x4 (&acc)[2][2][4][2], const Unit& u, int wr, int wc, int fr, int fq) const {
        const int row0 = u.pm * BM + wr * 64 + fr; const int col0 = u.pn * BM + wc * 32 + 8 * fq;
        u32x4 xw[2][4][2];
#pragma unroll
        for (int ai = 0; ai < 2; ++ai)
#pragma unroll
            for (int m = 0; m < 4; ++m)
#pragma unroll
                for (int bj = 0; bj < 2; ++bj) xw[ai][m][bj] = *(const u32x4*)(xb + (size_t)(row0 + ai * HALF + m * 16) * 1024 + col0 + bj * HALF);
#pragma unroll
        for (int ai = 0; ai < 2; ++ai)
#pragma unroll
            for (int m = 0; m < 4; ++m) { const int row = row0 + ai * HALF + m * 16; bf16_t* p = xb + (size_t)row * 1024 + col0; float s = 0.f;
#pragma unroll
                for (int bj = 0; bj < 2; ++bj) { const u32x4 x4 = xw[ai][m][bj]; f32x4 v0, v1;
                    v0[0] = __uint_as_float(x4.x << 16); v0[1] = __uint_as_float(x4.x & 0xffff0000u); v0[2] = __uint_as_float(x4.y << 16); v0[3] = __uint_as_float(x4.y & 0xffff0000u);
                    v1[0] = __uint_as_float(x4.z << 16); v1[1] = __uint_as_float(x4.z & 0xffff0000u); v1[2] = __uint_as_float(x4.w << 16); v1[3] = __uint_as_float(x4.w & 0xffff0000u);
                    v0 = v0 + acc[ai][bj][m][0] * scale; v1 = v1 + acc[ai][bj][m][1] * scale;
                    const u32x4 w = pack8(v0, v1); *(u32x4*)(p + bj * HALF) = w;
                    const float r0 = __uint_as_float(w.x << 16), r1 = __uint_as_float(w.x & 0xffff0000u), r2 = __uint_as_float(w.y << 16), r3 = __uint_as_float(w.y & 0xffff0000u);
                    const float r4 = __uint_as_float(w.z << 16), r5 = __uint_as_float(w.z & 0xffff0000u), r6 = __uint_as_float(w.w << 16), r7 = __uint_as_float(w.w & 0xffff0000u);
                    s += ((r0 * r0 + r1 * r1) + (r2 * r2 + r3 * r3)) + ((r4 * r4 + r5 * r5) + (r6 * r6 + r7 * r7)); }
                s += __shfl_xor(s, 16); s += __shfl_xor(s, 32);
                if (fq == 0) ssq[(size_t)row * 16 + u.pn * 4 + wc] = s; }
    }
};

__device__ __forceinline__ float sumsq8(const u32x4 w) {
    const float r0 = __uint_as_float(w.x << 16), r1 = __uint_as_float(w.x & 0xffff0000u), r2 = __uint_as_float(w.y << 16), r3 = __uint_as_float(w.y & 0xffff0000u);
    const float r4 = __uint_as_float(w.z << 16), r5 = __uint_as_float(w.z & 0xffff0000u), r6 = __uint_as_float(w.w << 16), r7 = __uint_as_float(w.w & 0xffff0000u);
    return ((r0 * r0 + r1 * r1) + (r2 * r2 + r3 * r3)) + ((r4 * r4 + r5 * r5) + (r6 * r6 + r7 * r7)); }
struct EpiResidFinal {
    static constexpr bool PERM = true, AFTER_DRAIN = false;
    const bf16_t* xb; float* ssq; float* out; const float* gain; unsigned* cnt; PG8_LAS float* rt; float scale;
    __device__ __forceinline__ void operator()(const f32x4 (&acc)[2][2][4][2], const Unit& u, int wr, int wc, int fr, int fq) const {
        const int row0 = u.pm * BM + wr * 64 + fr; const int col0 = u.pn * BM + wc * 32 + 8 * fq;
        u32x4 xn[2][4][2];
#pragma unroll
        for (int ai = 0; ai < 2; ++ai) {
            u32x4 xw[4][2];
#pragma unroll
            for (int m = 0; m < 4; ++m)
#pragma unroll
                for (int bj = 0; bj < 2; ++bj) xw[m][bj] = *(const u32x4*)(xb + (size_t)(row0 + ai * HALF + m * 16) * 1024 + col0 + bj * HALF);
#pragma unroll
            for (int m = 0; m < 4; ++m) { const int row = row0 + ai * HALF + m * 16; float s = 0.f;
#pragma unroll
                for (int bj = 0; bj < 2; ++bj) { const u32x4 x4 = xw[m][bj]; f32x4 v0, v1;
                    v0[0] = __uint_as_float(x4.x << 16); v0[1] = __uint_as_float(x4.x & 0xffff0000u); v0[2] = __uint_as_float(x4.y << 16); v0[3] = __uint_as_float(x4.y & 0xffff0000u);
                    v1[0] = __uint_as_float(x4.z << 16); v1[1] = __uint_as_float(x4.z & 0xffff0000u); v1[2] = __uint_as_float(x4.w << 16); v1[3] = __uint_as_float(x4.w & 0xffff0000u);
                    v0 = v0 + acc[ai][bj][m][0] * scale; v1 = v1 + acc[ai][bj][m][1] * scale;
                    const u32x4 w = pack8(v0, v1); xn[ai][m][bj] = w; s += sumsq8(w); }
                s += __shfl_xor(s, 16); s += __shfl_xor(s, 32);
                if (fq == 0) __hip_atomic_store(ssq + (size_t)row * 16 + u.pn * 4 + wc, s, __ATOMIC_RELAXED, __HIP_MEMORY_SCOPE_AGENT); }
        }
        asm volatile("s_waitcnt vmcnt(0)" ::: "memory");
        asm volatile("" ::: "memory"); __builtin_amdgcn_s_barrier(); asm volatile("" ::: "memory");
        if (threadIdx.x == 0) {
            unsigned* c = cnt + 64 * u.pm;
            __hip_atomic_fetch_add(c, 1u, __ATOMIC_RELAXED, __HIP_MEMORY_SCOPE_AGENT);
            unsigned sp = 0; while (__hip_atomic_load(c, __ATOMIC_RELAXED, __HIP_MEMORY_SCOPE_AGENT) < 4u && ++sp < (1u << 24)) __builtin_amdgcn_s_sleep(1);
            __builtin_amdgcn_fence(__ATOMIC_ACQUIRE, "agent");
            asm volatile("s_waitcnt vmcnt(0)" ::: "memory");
        }
        asm volatile("" ::: "memory"); __builtin_amdgcn_s_barrier(); asm volatile("" ::: "memory");
        { int t = threadIdx.x; asm volatile("" : "+v"(t)); if (t < 256) rt[t] = rstd1024(ssq, u.pm * BM + t); }
        asm volatile("s_waitcnt lgkmcnt(0)" ::: "memory");
        asm volatile("" ::: "memory"); __builtin_amdgcn_s_barrier(); asm volatile("" ::: "memory");
        f32x4 g[2][2];
#pragma unroll
        for (int bj = 0; bj < 2; ++bj) { g[bj][0] = *(const f32x4*)(gain + col0 + bj * HALF); g[bj][1] = *(const f32x4*)(gain + col0 + bj * HALF + 4); }
#pragma unroll
        for (int ai = 0; ai < 2; ++ai)
#pragma unroll
            for (int m = 0; m < 4; ++m) { const int rl_ = wr * 64 + fr + ai * HALF + m * 16; const float r = rt[rl_]; float* op = out + (size_t)(u.pm * BM + rl_) * 1024 + col0;
#pragma unroll
                for (int bj = 0; bj < 2; ++bj) { const u32x4 x4 = xn[ai][m][bj]; f32x4 v0, v1;
                    v0[0] = __uint_as_float(x4.x << 16); v0[1] = __uint_as_float(x4.x & 0xffff0000u); v0[2] = __uint_as_float(x4.y << 16); v0[3] = __uint_as_float(x4.y & 0xffff0000u);
                    v1[0] = __uint_as_float(x4.z << 16); v1[1] = __uint_as_float(x4.z & 0xffff0000u); v1[2] = __uint_as_float(x4.w << 16); v1[3] = __uint_as_float(x4.w & 0xffff0000u);
                    *(f32x4*)(op + bj * HALF) = v0 * r * g[bj][0]; *(f32x4*)(op + bj * HALF + 4) = v1 * r * g[bj][1]; } }
    }
};

struct EpiDiffQKV {
    static constexpr bool PERM = true, AFTER_DRAIN = false;
    bf16_t *Q, *K, *V; const PG8_LAS float* rtab; const float* cosT; const float* sinT; float qscale; mutable int ui;
    __device__ __forceinline__ void operator()(const f32x4 (&acc)[2][2][4][2], const Unit& u, int wr, int wc, int fr, int fq) const {
        const PG8_LAS float* rt = rtab + ui * 256 + wr * 64 + fr; ++ui;
        const int row0 = u.pm * BM + wr * 64 + fr;
        if (u.pn >= 8) {
            const int col0 = (u.pn - 8) * BM + wc * 32 + 8 * fq;
#pragma unroll
            for (int ai = 0; ai < 2; ++ai)
#pragma unroll
                for (int m = 0; m < 4; ++m) { const int row = row0 + ai * HALF + m * 16; const float r = rt[ai * HALF + m * 16];
#pragma unroll
                    for (int bj = 0; bj < 2; ++bj) *(u32x4*)(V + (size_t)row * 1024 + col0 + bj * HALF) = pack8(acc[ai][bj][m][0] * r, acc[ai][bj][m][1] * r); }
        } else {
            bf16_t* dst = (u.pn < 4) ? Q : K; const float sc = (u.pn < 4) ? qscale : 1.0f; const int col0 = (u.pn & 3) * BM + wc * 64 + 8 * fq;
#pragma unroll
            for (int ai = 0; ai < 2; ++ai) {
                f32x4 cs[4][2][2];
#pragma unroll
                for (int m = 0; m < 4; ++m)
#pragma unroll
                    for (int n = 0; n < 2; ++n) { const size_t ro = (size_t)(row0 + ai * HALF + m * 16) * 32 + 8 * fq + 4 * n; cs[m][n][0] = *(const f32x4*)(cosT + ro); cs[m][n][1] = *(const f32x4*)(sinT + ro); }
#pragma unroll
                for (int m = 0; m < 4; ++m) { const int row = row0 + ai * HALF + m * 16; const float r = rt[ai * HALF + m * 16] * sc;
                    f32x4 o1[2], o2[2];
#pragma unroll
                    for (int n = 0; n < 2; ++n) { const f32x4 c = cs[m][n][0], s = cs[m][n][1];
                        const f32x4 x1 = acc[ai][0][m][n] * r, x2 = acc[ai][1][m][n] * r; o1[n] = x1 * c - x2 * s; o2[n] = x2 * c + x1 * s; }
                    *(u32x4*)(dst + (size_t)row * 1024 + col0) = pack8(o1[0], o1[1]); *(u32x4*)(dst + (size_t)row * 1024 + col0 + 32) = pack8(o2[0], o2[1]); }
            }
        }
    }
};

struct EpiF32 {
    static constexpr bool PERM = false, AFTER_DRAIN = false;
    float* C; int ldc; const PG8_LAS float* rtab; mutable int ui;
    __device__ __forceinline__ void operator()(const f32x4 (&acc)[2][2][4][2], const Unit& u, int wr, int wc, int fr, int fq) const {
        const PG8_LAS float* rt = rtab + ui * 256 + wr * 64 + fr; ++ui;
        const int row0 = u.pm * BM + wr * 64 + fr; const int col0 = u.pn * BM + wc * 32 + 4 * fq;
#pragma unroll
        for (int ai = 0; ai < 2; ++ai)
#pragma unroll
            for (int m = 0; m < 4; ++m) { const int row = row0 + ai * HALF + m * 16; const float r = rt[ai * HALF + m * 16];
#pragma unroll
                for (int bj = 0; bj < 2; ++bj)
#pragma unroll
                    for (int n = 0; n < 2; ++n) *(f32x4*)(C + (size_t)row * ldc + col0 + bj * HALF + n * 16) = acc[ai][bj][m][n] * r; }
    }
};

struct EpiMlaQ {
    static constexpr bool PERM = true, AFTER_DRAIN = false;
    bf16_t* Qm; const float* cosT; const float* sinT; const PG8_LAS float* rtab; float qscale0; mutable int ui;
    __device__ __forceinline__ void operator()(const f32x4 (&acc)[2][2][4][2], const Unit& u, int wr, int wc, int fr, int fq) const {
        const PG8_LAS float* rt = rtab + ui * 256 + wr * 64 + fr; ++ui;
        const int row0 = u.pm * BM + wr * 64 + fr;
        if (u.pn < 4) {
#pragma unroll
            for (int ai = 0; ai < 2; ++ai)
#pragma unroll
                for (int m = 0; m < 4; ++m) { const int row = row0 + ai * HALF + m * 16; const float qscale = qscale0 * rt[ai * HALF + m * 16];
#pragma unroll
                    for (int bj = 0; bj < 2; ++bj) *(u32x4*)(Qm + (size_t)row * 1536 + (2 * u.pn + bj) * 192 + wc * 32 + 8 * fq) = pack8(acc[ai][bj][m][0] * qscale, acc[ai][bj][m][1] * qscale); }
        } else {
            const int h = 4 * (u.pn - 4) + wc;
#pragma unroll
            for (int ai = 0; ai < 2; ++ai) {
                f32x4 cs[4][2][2];
#pragma unroll
                for (int m = 0; m < 4; ++m)
#pragma unroll
                    for (int n = 0; n < 2; ++n) { const size_t ro = (size_t)(row0 + ai * HALF + m * 16) * 32 + 8 * fq + 4 * n; cs[m][n][0] = *(const f32x4*)(cosT + ro); cs[m][n][1] = *(const f32x4*)(sinT + ro); }
#pragma unroll
                for (int m = 0; m < 4; ++m) { const int row = row0 + ai * HALF + m * 16; const float qscale = qscale0 * rt[ai * HALF + m * 16];
                    f32x4 o1[2], o2[2];
#pragma unroll
                    for (int n = 0; n < 2; ++n) { const f32x4 c = cs[m][n][0], s = cs[m][n][1];
                        const f32x4 x1 = acc[ai][0][m][n] * qscale, x2 = acc[ai][1][m][n] * qscale; o1[n] = x1 * c - x2 * s; o2[n] = x2 * c + x1 * s; }
                    bf16_t* p = Qm + (size_t)row * 1536 + h * 192 + 128 + 8 * fq;
                    *(u32x4*)p = pack8(o1[0], o1[1]); *(u32x4*)(p + 32) = pack8(o2[0], o2[1]); }
            }
        }
    }
};

struct EpiMlaKV {
    static constexpr bool PERM = true, AFTER_DRAIN = false;
    bf16_t *Km, *V; const PG8_LAS float* rtab; mutable int ui;
    __device__ __forceinline__ void operator()(const f32x4 (&acc)[2][2][4][2], const Unit& u, int wr, int wc, int fr, int fq) const {
        const PG8_LAS float* rt = rtab + ui * 256 + wr * 64 + fr; ++ui;
        const int row0 = u.pm * BM + wr * 64 + fr; const int h = u.pn, j0 = wc * 32 + 8 * fq;
#pragma unroll
        for (int ai = 0; ai < 2; ++ai)
#pragma unroll
            for (int m = 0; m < 4; ++m) { const int row = row0 + ai * HALF + m * 16; const float r = rt[ai * HALF + m * 16];
                *(u32x4*)(Km + (size_t)row * 1536 + h * 192 + j0) = pack8(acc[ai][0][m][0] * r, acc[ai][0][m][1] * r);
                *(u32x4*)(V + (size_t)row * 1024 + h * 128 + j0) = pack8(acc[ai][1][m][0] * r, acc[ai][1][m][1] * r); }
    }
};

struct EpiMlaIn {
    static constexpr bool PERM = true, AFTER_DRAIN = false;
    bf16_t *CQ, *CKV, *Km; float* S16; const PG8_LAS float* rtab; const float* cosT; const float* sinT; mutable int ui;
    __device__ __forceinline__ void operator()(const f32x4 (&acc)[2][2][4][2], const Unit& u, int wr, int wc, int fr, int fq) const {
        const PG8_LAS float* rt = rtab + ui * 256 + wr * 64 + fr; ++ui;
        const int row0 = u.pm * BM + wr * 64 + fr, i0 = 8 * fq;
#pragma unroll
        for (int ai = 0; ai < 2; ++ai)
#pragma unroll
            for (int m = 0; m < 4; ++m) { const int row = row0 + ai * HALF + m * 16; const float r = rt[ai * HALF + m * 16];
                float sq = 0.f, skv = 0.f;
                if (u.pn == 2 && wc == 3) {
                    f32x4 o1[2], o2[2];
#pragma unroll
                    for (int n = 0; n < 2; ++n) { const size_t ro = (size_t)row * 32 + i0 + 4 * n; const f32x4 c = *(const f32x4*)(cosT + ro), s = *(const f32x4*)(sinT + ro);
                        const f32x4 x1 = acc[ai][0][m][n] * r, x2 = acc[ai][1][m][n] * r; o1[n] = x1 * c - x2 * s; o2[n] = x2 * c + x1 * s; }
                    const u32x4 w1 = pack8(o1[0], o1[1]), w2 = pack8(o2[0], o2[1]);
#pragma unroll
                    for (int h = 0; h < 8; ++h) { bf16_t* p = Km + (size_t)row * 1536 + h * 192 + 128 + i0; *(u32x4*)p = w1; *(u32x4*)(p + 32) = w2; }
                } else {
                    const u32x4 w0 = pack8(acc[ai][0][m][0] * r, acc[ai][0][m][1] * r), w1 = pack8(acc[ai][1][m][0] * r, acc[ai][1][m][1] * r);
                    if (u.pn == 0) { *(u32x4*)(CQ + (size_t)row * 384 + wc * 32 + i0) = w0; *(u32x4*)(CQ + (size_t)row * 384 + 128 + wc * 32 + i0) = w1; sq = sumsq8(w0) + sumsq8(w1); }
                    else if (u.pn == 1) { *(u32x4*)(CQ + (size_t)row * 384 + 256 + wc * 32 + i0) = w0; sq = sumsq8(w0); *(u32x4*)(CKV + (size_t)row * 256 + wc * 32 + i0) = w1; skv = sumsq8(w1); }
                    else { *(u32x4*)(CKV + (size_t)row * 256 + 128 + wc * 32 + i0) = w0; skv = sumsq8(w0);
                           if (wc == 0) { *(u32x4*)(CKV + (size_t)row * 256 + 224 + i0) = w1; skv += sumsq8(w1); } }
                }
                sq += __shfl_xor(sq, 16); sq += __shfl_xor(sq, 32); skv += __shfl_xor(skv, 16); skv += __shfl_xor(skv, 32);
                if (fq == 0) { float* sl = S16 + (size_t)row * 16;
                    if (u.pn == 0) sl[wc] = sq; else if (u.pn == 1) { sl[4 + wc] = sq; sl[8 + wc] = skv; } else sl[12 + wc] = skv; }
            }
    }
};

__device__ __forceinline__ float rstd_half(const float* s16, int row, int first, float inv_n) { const f32x4* p = (const f32x4*)(s16 + (size_t)row * 16 + first); const f32x4 a = p[0], b = p[1];
    const float s = ((a[0] + a[1]) + (a[2] + a[3])) + ((b[0] + b[1]) + (b[2] + b[3])); return rsqrtf(s * inv_n + NORM_EPS); }
template <int MODE, class Sched> __device__ __forceinline__ void rstd_table_fill(PG8_LAS float* tab, const Sched& S, const float* ssq, int max_units) {
    int tid = threadIdx.x; asm volatile("" : "+v"(tid));
    const int half = tid >> 8, rr = tid & 255;
    for (int i0 = 0; i0 < max_units; i0 += 2) { Unit u; const int i = i0 + half; if (i < max_units && S.next(i, u)) { const int row = u.pm * BM + rr;
        tab[i * 256 + rr] = (MODE == 0) ? rstd1024(ssq, row) : (MODE == 1) ? rstd_half(ssq, row, 0, 1.0f / 384.0f) : rstd_half(ssq, row, 8, 1.0f / 256.0f); } }
    asm volatile("s_waitcnt lgkmcnt(0)" ::: "memory");
    __syncthreads();
}
template <class Epi, class Sched, bool ALIGN_EPI = false, bool SP2 = false, int AUXA = 0  >
__device__ __forceinline__ void gemm_phase(PG8_LAS unsigned char* lds, const Gemm g, const Sched& S, const Epi& E) {
    int tid = threadIdx.x; asm volatile("" : "+v"(tid));
    const int wid = __builtin_amdgcn_readfirstlane(tid >> 6), lane = tid & 63, wr = wid >> 2, wc = wid & 3, fr = lane & 15, fq = lane >> 4;
    int K = g.K; asm volatile("" : "+s"(K));
    const int nt = K / BK;
    unsigned voffA[2], voffB[2];
#pragma unroll
    for (int i = 0; i < 2; ++i) { int R, C; stage_rc(tid * 16 + i * 8192, R, C); const int Rb = Epi::PERM ? ((R & ~31) + perm32(R & 31)) : R;
        voffA[i] = (unsigned)(R * K + C) * 2u; voffB[i] = (unsigned)(Rb * K + C) * 2u; }
    const size_t kstep = (size_t)(BK * 2);
    const size_t hstep = (size_t)HALF * K * 2;
    const size_t tstep = 2 * hstep;
    const unsigned ldsw = (unsigned)wid * 1024u;
    const int aoff = lds_byte(wr * 64 + fr, fq * 8), boff = lds_byte(wc * 32 + fr, fq * 8);
#define PG8_SA(b, h) (((b) * 2 + (h)) * HTB)
#define PG8_SB(b, h) ((4 + (b) * 2 + (h)) * HTB)
#define PG8_STAGE(bufoff, gbase, voff, aux) do { _Pragma("unroll") for (int _i = 0; _i < 2; ++_i) \
        __builtin_amdgcn_global_load_lds((const unsigned*)((const char*)(gbase) + (voff)[_i]), (PG8_LAS unsigned*)(lds + (bufoff) + ldsw + _i * 8192), 16, 0, (aux)); } while (0)
#define PG8_LDA(dst, b, h) do { _Pragma("unroll") for (int m = 0; m < 4; ++m) _Pragma("unroll") for (int k = 0; k < 2; ++k) dst[m][k] = *(const PG8_LAS bf16x8*)(lds + PG8_SA(b, h) + aoff + m * 2048 + k * 1024); } while (0)
#define PG8_LDB(dst, b, h) do { _Pragma("unroll") for (int n = 0; n < 2; ++n) _Pragma("unroll") for (int k = 0; k < 2; ++k) dst[n][k] = *(const PG8_LAS bf16x8*)(lds + PG8_SB(b, h) + boff + n * 2048 + k * 1024); } while (0)
#define PG8_MMA(ai, bj, At, Bt) do { __builtin_amdgcn_s_setprio(1); _Pragma("unroll") for (int m = 0; m < 4; ++m) _Pragma("unroll") for (int n = 0; n < 2; ++n) _Pragma("unroll") for (int k = 0; k < 2; ++k) \
        acc[ai][bj][m][n] = __builtin_amdgcn_mfma_f32_16x16x32_bf16(Bt[n][k], At[m][k], acc[ai][bj][m][n], 0, 0, 0); __builtin_amdgcn_s_setprio(0); } while (0)
#define PG8_WAIT_V(n) asm volatile("s_waitcnt vmcnt(" #n ")" ::: "memory")
#define PG8_WAIT_L(n) asm volatile("s_waitcnt lgkmcnt(" #n ")" ::: "memory")
#define PG8_BAR __builtin_amdgcn_s_barrier()
#define PG8_SCHED __builtin_amdgcn_sched_barrier(0)
    Unit cur, nxt; int ui = 0;
    if (!S.next(0, cur)) return;
    f32x4 acc[2][2][4][2];
#pragma unroll
    for (int a = 0; a < 2; ++a)
#pragma unroll
        for (int b = 0; b < 2; ++b)
#pragma unroll
            for (int m = 0; m < 4; ++m)
#pragma unroll
                for (int n = 0; n < 2; ++n) acc[a][b][m][n] = (f32x4){0.f, 0.f, 0.f, 0.f};
    bf16x8 At[4][2], B0[2][2], B1[2][2];
    const char* cA = (const char*)g.A + (size_t)cur.pm * tstep; const char* cB = (const char*)g.Bt + (size_t)cur.pn * tstep;
    S.a_ready(cur);
    if constexpr (SP2) {
        PG8_STAGE(PG8_SB(0, 0), cB, voffB, 0); PG8_STAGE(PG8_SB(0, 1), cB + hstep, voffB, 0); PG8_STAGE(PG8_SA(0, 0), cA, voffA, AUXA); PG8_STAGE(PG8_SA(0, 1), cA + hstep, voffA, AUXA);
        if (wr == 1) PG8_BAR;
        PG8_WAIT_V(2); PG8_BAR;
        PG8_STAGE(PG8_SB(1, 0), cB + kstep, voffB, 0); PG8_STAGE(PG8_SA(1, 0), cA + kstep, voffA, AUXA); PG8_STAGE(PG8_SB(1, 1), cB + hstep + kstep, voffB, 0);
        PG8_WAIT_V(6); PG8_BAR;
    } else {
        PG8_STAGE(PG8_SB(0, 0), cB, voffB, 0); PG8_STAGE(PG8_SA(0, 0), cA, voffA, AUXA); PG8_STAGE(PG8_SB(0, 1), cB + hstep, voffB, 0); PG8_STAGE(PG8_SA(0, 1), cA + hstep, voffA, AUXA);
        if (wr == 1) PG8_BAR;
        PG8_WAIT_V(4); PG8_BAR;
        PG8_STAGE(PG8_SB(1, 0), cB + kstep, voffB, 0); PG8_STAGE(PG8_SA(1, 0), cA + kstep, voffA, AUXA); PG8_STAGE(PG8_SB(1, 1), cB + hstep + kstep, voffB, 0);
        PG8_WAIT_V(6); PG8_BAR;
    }
    for (;;) {
        const bool has_next = S.next(ui + 1, nxt);
        const char* nA = has_next ? (const char*)g.A + (size_t)nxt.pm * tstep : cA; const char* nB = has_next ? (const char*)g.Bt + (size_t)nxt.pn * tstep : cB;
        for (int t = 0; t < nt; t += 2) {
            const bool last = (t == nt - 2);
            const char* a1 = cA + (size_t)(t + 1) * kstep;
            const char* a2 = last ? nA : cA + (size_t)(t + 2) * kstep; const char* b2 = last ? nB : cB + (size_t)(t + 2) * kstep;
            const char* a3 = a2 + kstep; const char* b3 = b2 + kstep;
            if (last && has_next) S.a_ready(nxt);
            if constexpr (SP2) {
            PG8_LDB(B0, 0, 0); PG8_LDB(B1, 0, 1); PG8_SCHED; PG8_LDA(At, 0, 0); PG8_STAGE(PG8_SA(1, 1), a1 + hstep, voffA, AUXA);
            PG8_WAIT_V(8); PG8_WAIT_L(0); PG8_BAR; PG8_MMA(0, 0, At, B0); PG8_MMA(0, 1, At, B1); PG8_BAR; PG8_SCHED;
            PG8_LDA(At, 0, 1); PG8_STAGE(PG8_SB(0, 0), b2, voffB, 0); PG8_STAGE(PG8_SB(0, 1), b2 + hstep, voffB, 0); PG8_STAGE(PG8_SA(0, 0), a2, voffA, AUXA);
            PG8_WAIT_V(8); PG8_WAIT_L(0); PG8_BAR; PG8_MMA(1, 0, At, B0); PG8_MMA(1, 1, At, B1); PG8_BAR; PG8_SCHED;
            PG8_LDB(B0, 1, 0); PG8_LDB(B1, 1, 1); PG8_SCHED; PG8_LDA(At, 1, 0); PG8_STAGE(PG8_SA(0, 1), a2 + hstep, voffA, AUXA);
            PG8_WAIT_V(8); PG8_WAIT_L(0); PG8_BAR; PG8_MMA(0, 0, At, B0); PG8_MMA(0, 1, At, B1); PG8_BAR; PG8_SCHED;
            PG8_LDA(At, 1, 1); PG8_STAGE(PG8_SB(1, 0), b3, voffB, 0); PG8_STAGE(PG8_SB(1, 1), b3 + hstep, voffB, 0); PG8_STAGE(PG8_SA(1, 0), a3, voffA, AUXA);
            PG8_WAIT_V(8); PG8_WAIT_L(0); PG8_BAR; PG8_MMA(1, 0, At, B0); PG8_MMA(1, 1, At, B1); PG8_BAR; PG8_SCHED;
            } else {
            PG8_LDB(B0, 0, 0); PG8_SCHED; PG8_LDA(At, 0, 0); PG8_STAGE(PG8_SA(1, 1), a1 + hstep, voffA, AUXA);
            PG8_WAIT_L(8); PG8_BAR; PG8_WAIT_L(0); PG8_MMA(0, 0, At, B0); PG8_BAR; PG8_SCHED;
            PG8_LDB(B1, 0, 1); PG8_STAGE(PG8_SB(0, 0), b2, voffB, 0);
            PG8_BAR; PG8_WAIT_L(0); PG8_MMA(0, 1, At, B1); PG8_BAR;
            PG8_LDA(At, 0, 1); PG8_STAGE(PG8_SA(0, 0), a2, voffA, AUXA);
            PG8_BAR; PG8_WAIT_L(0); PG8_MMA(1, 0, At, B0); PG8_BAR; PG8_SCHED;
            PG8_STAGE(PG8_SB(0, 1), b2 + hstep, voffB, 0);
            PG8_WAIT_V(6); PG8_BAR; PG8_MMA(1, 1, At, B1); PG8_BAR;
            PG8_LDB(B0, 1, 0); PG8_SCHED; PG8_LDA(At, 1, 0); PG8_STAGE(PG8_SA(0, 1), a2 + hstep, voffA, AUXA);
            PG8_WAIT_L(8); PG8_BAR; PG8_WAIT_L(0); PG8_MMA(0, 0, At, B0); PG8_BAR; PG8_SCHED;
            PG8_LDB(B1, 1, 1); PG8_STAGE(PG8_SB(1, 0), b3, voffB, 0);
            PG8_BAR; PG8_WAIT_L(0); PG8_MMA(0, 1, At, B1); PG8_BAR;
            PG8_LDA(At, 1, 1); PG8_STAGE(PG8_SA(1, 0), a3, voffA, AUXA);
            PG8_BAR; PG8_WAIT_L(0); PG8_MMA(1, 0, At, B0); PG8_BAR; PG8_SCHED;
            PG8_STAGE(PG8_SB(1, 1), b3 + hstep, voffB, 0);
            PG8_WAIT_V(6); PG8_BAR; PG8_MMA(1, 1, At, B1); PG8_BAR;
            }
        }
        if constexpr (ALIGN_EPI) { if (wr == 0) PG8_BAR; }
        if constexpr (!Epi::AFTER_DRAIN) { E(acc, cur, wr, wc, fr, fq); S.done(cur); }
        if (!has_next) break;
#pragma unroll
        for (int a = 0; a < 2; ++a)
#pragma unroll
            for (int b = 0; b < 2; ++b)
#pragma unroll
                for (int m = 0; m < 4; ++m)
#pragma unroll
                    for (int n = 0; n < 2; ++n) acc[a][b][m][n] = (f32x4){0.f, 0.f, 0.f, 0.f};
        cur = nxt; cA = nA; cB = nB; ++ui;
        if constexpr (ALIGN_EPI) { if (wr == 1) PG8_BAR; }
    }
    PG8_WAIT_V(0);
    if constexpr (!ALIGN_EPI) { if (wr == 0) PG8_BAR; }
    PG8_BAR;
    if constexpr (Epi::AFTER_DRAIN) { E.fused(acc, cur, wr, wc, fr, fq, lds, wid, lane); S.done(cur); }
#undef PG8_SA
#undef PG8_SB
#undef PG8_STAGE
#undef PG8_LDA
#undef PG8_LDB
#undef PG8_MMA
#undef PG8_WAIT_V
#undef PG8_WAIT_L
#undef PG8_BAR
#undef PG8_SCHED
}
}

constexpr int BATCH = 8, SEQ = 4096, DM = 1024, DFF = 2816, MTOK = BATCH * SEQ;
constexpr int NWAVES = 8;
#define LAS __attribute__((address_space(3)))
typedef unsigned short bf16;
typedef unsigned v4u __attribute__((ext_vector_type(4)));
typedef float f32x4 __attribute__((ext_vector_type(4)));
typedef float f32x2 __attribute__((ext_vector_type(2)));
__device__ __forceinline__ unsigned f2bf(float f) { unsigned u = __builtin_bit_cast(unsigned, f); return (u + 0x7fffu + ((u >> 16) & 1u)) >> 16; }
__device__ __forceinline__ unsigned pk2(float lo, float hi) { return f2bf(lo) | (f2bf(hi) << 16); }
__device__ __forceinline__ float wave_sum(float v) {
#pragma unroll
    for (int o = 1; o < 64; o <<= 1) v += __shfl_xor(v, o);
    return v;
}

namespace att {
typedef short bf16x8 __attribute__((ext_vector_type(8)));
typedef short s16x4 __attribute__((ext_vector_type(4)));
typedef short v4i16_t __attribute__((ext_vector_type(4)));
typedef float f32x16 __attribute__((ext_vector_type(16)));
typedef unsigned u32x4 __attribute__((ext_vector_type(4)));
constexpr int VP = 320;
template <int DQK> struct Geo { static constexpr int KP = (DQK + 8) * 2, KBUF = 64 * KP, VBUF = 64 * VP, VOFF = 2 * KBUF, WS_OFF = 2 * KBUF + 3 * VBUF, NKC = DQK / 64, CK = DQK / 8, LDS_NEED = WS_OFF + 8 * 256; };
__device__ __forceinline__ int crow(int r, int hi) { return (r & 3) + 8 * (r >> 2) + 4 * hi; }
__device__ __forceinline__ unsigned cvtpk(float lo, float hi) { typedef float f2 __attribute__((ext_vector_type(2))); typedef __bf16 b2 __attribute__((ext_vector_type(2))); f2 v = {lo, hi}; b2 b = __builtin_convertvector(v, b2); return __builtin_bit_cast(unsigned, b); }
__device__ __forceinline__ float xhalf_max(float m) { auto rr = __builtin_amdgcn_permlane32_swap(__float_as_uint(m), __float_as_uint(m), false, false); return fmaxf(__uint_as_float(rr[0]), __uint_as_float(rr[1])); }
__device__ __forceinline__ float xhalf_sum(float m) { auto rr = __builtin_amdgcn_permlane32_swap(__float_as_uint(m), __float_as_uint(m), false, false); return __uint_as_float(rr[0]) + __uint_as_float(rr[1]); }
__device__ __forceinline__ s16x4 vtr(const LAS unsigned char* p) { return __builtin_bit_cast(s16x4, __builtin_amdgcn_ds_read_tr16_b64_v4i16((LAS v4i16_t*)p)); }
#define ATT_MAX3(a, b, c) __builtin_fmaxf(__builtin_fmaxf((a), (b)), (c))

template <int DQK>
__device__ __forceinline__ void attn_pass(LAS unsigned char* lds, const bf16* Qp, int qpitch, const bf16* Kp, int kpitch, const bf16* Vp, int vpitch, int q0, f32x16 (&o)[4], float (&rl)[16]) {
    typedef Geo<DQK> G;
    constexpr float THR = 8.0f;
    constexpr bool NEGM = (DQK <= 64);
    int tid = threadIdx.x; asm volatile("" : "+v"(tid));
    const int lane = tid & 63, r32 = lane & 31, hi = lane >> 5;
    const int wid = __builtin_amdgcn_readfirstlane(tid >> 6);
    const bool shifted = (DQK <= 64) && wid >= 4;
    LAS float* wsf = (LAS float*)(lds + G::WS_OFF) + wid * 64;
    bf16x8 qf[DQK / 16];
    { const bf16* qrow = Qp + (size_t)(q0 + wid * 32 + r32) * qpitch + 8 * hi;
#pragma unroll
      for (int d0 = 0; d0 < DQK / 16; ++d0) qf[d0] = *(const bf16x8*)(qrow + 16 * d0); }
    const int NT = (q0 + 256) / 64;
    const int qw0 = q0 + wid * 32;
    constexpr bool PF2 = (DQK <= 64);
    u32x4 kreg[G::NKC], vreg[2], kreg2[G::NKC], vreg2[2];
    unsigned kgo[G::NKC], vgo[2];
#pragma unroll
    for (int i = 0; i < G::NKC; ++i) { const int id = tid + 512 * i, row = id / G::CK, ch = id % G::CK; kgo[i] = (unsigned)(row * kpitch + ch * 8) * 2u; }
#pragma unroll
    for (int i = 0; i < 2; ++i) { const int id = tid + 512 * i, row = id >> 4, ch = id & 15; vgo[i] = (unsigned)(row * vpitch + ch * 8) * 2u; }
#define ATT_LOADS(KR, VR, t) do { const char* kt_ = (const char*)(Kp + (size_t)(64 * (t)) * kpitch); const char* vt_ = (const char*)(Vp + (size_t)(64 * (t)) * vpitch); \
        _Pragma("unroll") for (int i = 0; i < G::NKC; ++i) KR[i] = *(const u32x4*)(kt_ + kgo[i]); \
        _Pragma("unroll") for (int i = 0; i < 2; ++i) VR[i] = *(const u32x4*)(vt_ + vgo[i]); } while (0)
#define ATT_STORES(KR, VR, kb_, vb_) do { \
        _Pragma("unroll") for (int i = 0; i < G::NKC; ++i) { const int id = tid + 512 * i, row = id / G::CK, ch = id % G::CK; *(LAS u32x4*)(lds + (kb_) * G::KBUF + row * G::KP + ch * 16) = KR[i]; } \
        _Pragma("unroll") for (int i = 0; i < 2; ++i) { const int id = tid + 512 * i, row = id >> 4, ch = id & 15; *(LAS u32x4*)(lds + G::VOFF + (vb_) * G::VBUF + row * VP + ch * 16) = VR[i]; } } while (0)
#define ATT_LOAD(t) ATT_LOADS(kreg, vreg, t)
#define ATT_STORE(kb_, vb_) ATT_STORES(kreg, vreg, kb_, vb_)
#define ATT_BAR() asm volatile("s_waitcnt lgkmcnt(0)\n\ts_barrier" ::: "memory")
#pragma unroll
    for (int db = 0; db < 4; ++db)
#pragma unroll
        for (int r = 0; r < 16; ++r) o[db][r] = 0.f;
    float mhat = 0.f, l = 0.f;
    f32x16 negm;
#pragma unroll
    for (int r = 0; r < 16; ++r) negm[r] = 0.f;
    u32x4 pw[4];
#define ATT_A(t) do { \
        f32x16 p0, p1; \
        const LAS unsigned char* kb = lds + ((t) & 1) * G::KBUF + r32 * G::KP + hi * 16; \
        __builtin_amdgcn_s_setprio(1); \
        _Pragma("unroll") for (int d0 = 0; d0 < DQK / 16; ++d0) { \
            const bf16x8 k0 = *(const LAS bf16x8*)(kb + 32 * d0), k1 = *(const LAS bf16x8*)(kb + 32 * G::KP + 32 * d0); \
            if (d0 == 0) { if (NEGM) { p0 = __builtin_amdgcn_mfma_f32_32x32x16_bf16(k0, qf[0], negm, 0, 0, 0); p1 = __builtin_amdgcn_mfma_f32_32x32x16_bf16(k1, qf[0], negm, 0, 0, 0); } \
                           else { f32x16 z; _Pragma("unroll") for (int r = 0; r < 16; ++r) z[r] = 0.f; p0 = __builtin_amdgcn_mfma_f32_32x32x16_bf16(k0, qf[0], z, 0, 0, 0); p1 = __builtin_amdgcn_mfma_f32_32x32x16_bf16(k1, qf[0], z, 0, 0, 0); } } \
            else { p0 = __builtin_amdgcn_mfma_f32_32x32x16_bf16(k0, qf[d0], p0, 0, 0, 0); p1 = __builtin_amdgcn_mfma_f32_32x32x16_bf16(k1, qf[d0], p1, 0, 0, 0); } } \
        __builtin_amdgcn_s_setprio(0); \
        if (!NEGM) { _Pragma("unroll") for (int r = 0; r < 16; ++r) { p0[r] -= mhat; p1[r] -= mhat; } } \
        if (64 * (t) + 63 > qw0) { const int qg = qw0 + r32, kb0 = 64 * (t) + 4 * hi; \
            _Pragma("unroll") for (int r = 0; r < 16; ++r) { const int kv = kb0 + (r & 3) + 8 * (r >> 2); if (kv > qg) p0[r] = -INFINITY; if (kv + 32 > qg) p1[r] = -INFINITY; } } \
        float ra = ATT_MAX3(p0[0], p0[1], p1[0]), rb = ATT_MAX3(p0[2], p0[3], p1[1]); ra = ATT_MAX3(ra, p1[2], p1[3]); \
        _Pragma("unroll") for (int r = 4; r < 16; r += 4) { ra = ATT_MAX3(ra, p0[r], p0[r + 1]); rb = ATT_MAX3(rb, p0[r + 2], p0[r + 3]); ra = ATT_MAX3(ra, p1[r], p1[r + 1]); rb = ATT_MAX3(rb, p1[r + 2], p1[r + 3]); } \
        const float rm = xhalf_max(fmaxf(ra, rb)); \
        if ((t) == 0 || __any(rm > THR)) { \
            const float dl = ((t) == 0) ? rm : fmaxf(rm, 0.f); mhat += dl; \
            _Pragma("unroll") for (int r = 0; r < 16; ++r) { p0[r] -= dl; p1[r] -= dl; if (NEGM) negm[r] = -mhat; } \
            if ((t) != 0) { const float f = __builtin_amdgcn_exp2f(-dl); l *= f; \
                if (hi == 0) wsf[r32] = f; \
                asm volatile("s_waitcnt lgkmcnt(0)" ::: "memory"); \
                float fr_[16]; \
                _Pragma("unroll") for (int r = 0; r < 16; ++r) fr_[r] = wsf[crow(r, hi)]; \
                _Pragma("unroll") for (int db = 0; db < 4; ++db) _Pragma("unroll") for (int r = 0; r < 16; ++r) o[db][r] *= fr_[r]; \
                asm volatile("s_waitcnt lgkmcnt(0)" ::: "memory"); } } \
        float s = 0.f; \
        _Pragma("unroll") for (int r = 0; r < 16; ++r) { p0[r] = __builtin_amdgcn_exp2f(p0[r]); p1[r] = __builtin_amdgcn_exp2f(p1[r]); s += p0[r] + p1[r]; } \
        l += s; \
        _Pragma("unroll") for (int w = 0; w < 4; ++w) { pw[0][w] = cvtpk(p0[2 * w], p0[2 * w + 1]); pw[1][w] = cvtpk(p0[8 + 2 * w], p0[9 + 2 * w]); pw[2][w] = cvtpk(p1[2 * w], p1[2 * w + 1]); pw[3][w] = cvtpk(p1[8 + 2 * w], p1[9 + 2 * w]); } \
    } while (0)
#define ATT_B(vbi) do { \
        const LAS unsigned char* vb = lds + G::VOFF + (vbi) * G::VBUF + (4 * hi + ((lane & 15) >> 2)) * VP + ((lane >> 4) & 1) * 32 + (lane & 3) * 8; \
        __builtin_amdgcn_s_setprio(1); \
        _Pragma("unroll") for (int c = 0; c < 4; ++c) { const bf16x8 pa = __builtin_bit_cast(bf16x8, pw[c]); \
            _Pragma("unroll") for (int db = 0; db < 4; ++db) { \
                const s16x4 lo = vtr(vb + c * 16 * VP + db * 64), hh = vtr(vb + c * 16 * VP + 8 * VP + db * 64); \
                const bf16x8 vf = {lo[0], lo[1], lo[2], lo[3], hh[0], hh[1], hh[2], hh[3]}; \
                o[db] = __builtin_amdgcn_mfma_f32_32x32x16_bf16(pa, vf, o[db], 0, 0, 0); } } \
        __builtin_amdgcn_s_setprio(0); \
    } while (0)
#define ATT_VIS(t) (64 * (t) <= qw0 + 31)
    ATT_LOAD(0); ATT_STORE(0, 0);
    if (PF2) ATT_LOADS(kreg2, vreg2, 1);
    ATT_BAR();
    int vcur = 0;
#define ATT_VNEXT(v) (((v) == 2) ? 0 : (v) + 1)
    if (PF2) {
        if (!shifted) {
            for (int t = 0; t < NT; t += 2) {
                const int v1 = ATT_VNEXT(vcur), v2 = ATT_VNEXT(v1);
                if (t + 2 < NT) ATT_LOADS(kreg, vreg, t + 2);
                if (ATT_VIS(t)) { ATT_A(t); ATT_B(vcur); }
                ATT_STORES(kreg2, vreg2, 1, v1);
                ATT_BAR();
                if (t + 3 < NT) ATT_LOADS(kreg2, vreg2, t + 3);
                if (ATT_VIS(t + 1)) { ATT_A(t + 1); ATT_B(v1); }
                if (t + 2 < NT) ATT_STORES(kreg, vreg, 0, v2);
                ATT_BAR();
                vcur = v2;
            }
        } else {
            int vprev = 2;
            for (int t = 0; t < NT; t += 2) {
                const int v1 = ATT_VNEXT(vcur), v2 = ATT_VNEXT(v1);
                if (t + 2 < NT) ATT_LOADS(kreg, vreg, t + 2);
                if (t > 0 && ATT_VIS(t - 1)) ATT_B(vprev);
                if (ATT_VIS(t)) ATT_A(t);
                ATT_STORES(kreg2, vreg2, 1, v1);
                ATT_BAR();
                if (t + 3 < NT) ATT_LOADS(kreg2, vreg2, t + 3);
                if (ATT_VIS(t)) ATT_B(vcur);
                if (ATT_VIS(t + 1)) ATT_A(t + 1);
                if (t + 2 < NT) ATT_STORES(kreg, vreg, 0, v2);
                ATT_BAR();
                vprev = v1; vcur = v2;
            }
            if (ATT_VIS(NT - 1)) ATT_B(vprev);
        }
    } else {
        for (int t = 0; t < NT; ++t) {
            const int vnext = ATT_VNEXT(vcur);
            if (t + 1 < NT) ATT_LOAD(t + 1);
            if (ATT_VIS(t)) { ATT_A(t); ATT_B(vcur); }
            if (t + 1 < NT) ATT_STORE((t + 1) & 1, vnext);
            vcur = vnext;
            ATT_BAR();
        }
    }
    ATT_BAR();
#undef ATT_LOAD
#undef ATT_STORE
#undef ATT_LOADS
#undef ATT_STORES
#undef ATT_BAR
#undef ATT_VNEXT
#undef ATT_A
#undef ATT_B
#undef ATT_VIS
    l = xhalf_sum(l);
    if (hi == 0) wsf[32 + r32] = l;
    asm volatile("s_waitcnt lgkmcnt(0)" ::: "memory");
#pragma unroll
    for (int r = 0; r < 16; ++r) rl[r] = 1.0f / wsf[32 + crow(r, hi)];
    asm volatile("s_waitcnt lgkmcnt(0)" ::: "memory");
}
__device__ __forceinline__ void glds16(const void* gsrc, unsigned lds_dst) { unsigned keep;
    asm volatile("s_mov_b32 %0, m0\n\ts_mov_b32 m0, %2\n\ts_nop 0\n\tglobal_load_lds_dwordx4 %1, off\n\ts_mov_b32 m0, %0" : "=&s"(keep) : "v"(gsrc), "s"(lds_dst) : "memory"); }
template <int DQK>
__device__ __forceinline__ void attn_pass4(LAS unsigned char* lds, const bf16* Qp, int qpitch, const bf16* Kp, int kpitch, const bf16* Vp, int vpitch, int q0, f32x16 (&o)[4], float (&rl)[16]) {
    typedef Geo<DQK> G;
    constexpr float THR = 8.0f;
    constexpr bool NEGM = true;
    int tid = threadIdx.x; asm volatile("" : "+v"(tid));
    const int lane = tid & 63, r32 = lane & 31, hi = lane >> 5;
    const int wid = __builtin_amdgcn_readfirstlane(tid >> 6);
    const bool shifted = wid >= 4;
    LAS float* wsf = (LAS float*)(lds + G::WS_OFF) + wid * 64;
    bf16x8 qf[DQK / 16];
    { const bf16* qrow = Qp + (size_t)(q0 + wid * 32 + r32) * qpitch + 8 * hi;
#pragma unroll
      for (int d0 = 0; d0 < DQK / 16; ++d0) qf[d0] = *(const bf16x8*)(qrow + 16 * d0); }
    const int NT = (q0 + 256) / 64;
    const int qw0 = q0 + wid * 32;
    const unsigned lds0 = (unsigned)(size_t)lds;
    constexpr int KS = G::KP / 16, KD = DQK / 8, KJ = (KS + 7) / 8, VS = VP / 16, VD = 16, VJ = (VS + 7) / 8;
    unsigned koff[KJ], voff[VJ];
#pragma unroll
    for (int j = 0; j < KJ; ++j) { const int sidx = (j * 8 + wid) * 64 + lane, row = (sidx / KS) & 63, c = sidx % KS; koff[j] = (unsigned)(row * kpitch + (c < KD ? c : KD - 1) * 8) * 2u; }
#pragma unroll
    for (int j = 0; j < VJ; ++j) { const int sidx = (j * 8 + wid) * 64 + lane, row = (sidx / VS) & 63, c = sidx % VS; voff[j] = (unsigned)(row * vpitch + (c < VD ? c : VD - 1) * 8) * 2u; }
#define ATT_DMA(t, kb_, vb_) do { const char* kt_ = (const char*)(Kp + (size_t)(64 * (t)) * kpitch); const char* vt_ = (const char*)(Vp + (size_t)(64 * (t)) * vpitch); \
        _Pragma("unroll") for (int j = 0; j < KJ; ++j) { const int q = j * 8 + wid; if (q < KS) glds16(kt_ + koff[j], (unsigned)__builtin_amdgcn_readfirstlane((int)(lds0 + (unsigned)((kb_) * G::KBUF + q * 1024)))); } \
        _Pragma("unroll") for (int j = 0; j < VJ; ++j) { const int q = j * 8 + wid; if (q < VS) glds16(vt_ + voff[j], (unsigned)__builtin_amdgcn_readfirstlane((int)(lds0 + (unsigned)(G::VOFF + (vb_) * G::VBUF + q * 1024)))); } } while (0)
#define ATT_BAR() asm volatile("s_waitcnt vmcnt(0) lgkmcnt(0)\n\ts_barrier" ::: "memory")
#pragma unroll
    for (int db = 0; db < 4; ++db)
#pragma unroll
        for (int r = 0; r < 16; ++r) o[db][r] = 0.f;
    float mhat = 0.f, l = 0.f;
    f32x16 negm;
#pragma unroll
    for (int r = 0; r < 16; ++r) negm[r] = 0.f;
    u32x4 pw[4];
#define ATT_A(t) do { \
        f32x16 p0, p1; \
        const LAS unsigned char* kb = lds + ((t) & 1) * G::KBUF + r32 * G::KP + hi * 16; \
        __builtin_amdgcn_s_setprio(1); \
        _Pragma("unroll") for (int d0 = 0; d0 < DQK / 16; ++d0) { \
            const bf16x8 k0 = *(const LAS bf16x8*)(kb + 32 * d0), k1 = *(const LAS bf16x8*)(kb + 32 * G::KP + 32 * d0); \
            if (d0 == 0) { if (NEGM) { p0 = __builtin_amdgcn_mfma_f32_32x32x16_bf16(k0, qf[0], negm, 0, 0, 0); p1 = __builtin_amdgcn_mfma_f32_32x32x16_bf16(k1, qf[0], negm, 0, 0, 0); } \
                           else { f32x16 z; _Pragma("unroll") for (int r = 0; r < 16; ++r) z[r] = 0.f; p0 = __builtin_amdgcn_mfma_f32_32x32x16_bf16(k0, qf[0], z, 0, 0, 0); p1 = __builtin_amdgcn_mfma_f32_32x32x16_bf16(k1, qf[0], z, 0, 0, 0); } } \
            else { p0 = __builtin_amdgcn_mfma_f32_32x32x16_bf16(k0, qf[d0], p0, 0, 0, 0); p1 = __builtin_amdgcn_mfma_f32_32x32x16_bf16(k1, qf[d0], p1, 0, 0, 0); } } \
        __builtin_amdgcn_s_setprio(0); \
        if (!NEGM) { _Pragma("unroll") for (int r = 0; r < 16; ++r) { p0[r] -= mhat; p1[r] -= mhat; } } \
        if (64 * (t) + 63 > qw0) { const int qg = qw0 + r32, kb0 = 64 * (t) + 4 * hi; \
            _Pragma("unroll") for (int r = 0; r < 16; ++r) { const int kv = kb0 + (r & 3) + 8 * (r >> 2); if (kv > qg) p0[r] = -INFINITY; if (kv + 32 > qg) p1[r] = -INFINITY; } } \
        float ra = ATT_MAX3(p0[0], p0[1], p1[0]), rb = ATT_MAX3(p0[2], p0[3], p1[1]); ra = ATT_MAX3(ra, p1[2], p1[3]); \
        _Pragma("unroll") for (int r = 4; r < 16; r += 4) { ra = ATT_MAX3(ra, p0[r], p0[r + 1]); rb = ATT_MAX3(rb, p0[r + 2], p0[r + 3]); ra = ATT_MAX3(ra, p1[r], p1[r + 1]); rb = ATT_MAX3(rb, p1[r + 2], p1[r + 3]); } \
        const float rm = xhalf_max(fmaxf(ra, rb)); \
        if ((t) == 0 || __any(rm > THR)) { \
            const float dl = ((t) == 0) ? rm : fmaxf(rm, 0.f); mhat += dl; \
            _Pragma("unroll") for (int r = 0; r < 16; ++r) { p0[r] -= dl; p1[r] -= dl; if (NEGM) negm[r] = -mhat; } \
            if ((t) != 0) { const float f = __builtin_amdgcn_exp2f(-dl); l *= f; \
                if (hi == 0) wsf[r32] = f; \
                asm volatile("s_waitcnt lgkmcnt(0)" ::: "memory"); \
                float fr_[16]; \
                _Pragma("unroll") for (int r = 0; r < 16; ++r) fr_[r] = wsf[crow(r, hi)]; \
                _Pragma("unroll") for (int db = 0; db < 4; ++db) _Pragma("unroll") for (int r = 0; r < 16; ++r) o[db][r] *= fr_[r]; \
                asm volatile("s_waitcnt lgkmcnt(0)" ::: "memory"); } } \
        float s = 0.f; \
        _Pragma("unroll") for (int r = 0; r < 16; ++r) { p0[r] = __builtin_amdgcn_exp2f(p0[r]); p1[r] = __builtin_amdgcn_exp2f(p1[r]); s += p0[r] + p1[r]; } \
        l += s; \
        _Pragma("unroll") for (int w = 0; w < 4; ++w) { pw[0][w] = cvtpk(p0[2 * w], p0[2 * w + 1]); pw[1][w] = cvtpk(p0[8 + 2 * w], p0[9 + 2 * w]); pw[2][w] = cvtpk(p1[2 * w], p1[2 * w + 1]); pw[3][w] = cvtpk(p1[8 + 2 * w], p1[9 + 2 * w]); } \
    } while (0)
#define ATT_B(vbi) do { \
        const LAS unsigned char* vb = lds + G::VOFF + (vbi) * G::VBUF + (4 * hi + ((lane & 15) >> 2)) * VP + ((lane >> 4) & 1) * 32 + (lane & 3) * 8; \
        __builtin_amdgcn_s_setprio(1); \
        _Pragma("unroll") for (int c = 0; c < 4; ++c) { const bf16x8 pa = __builtin_bit_cast(bf16x8, pw[c]); \
            _Pragma("unroll") for (int db = 0; db < 4; ++db) { \
                const s16x4 lo = vtr(vb + c * 16 * VP + db * 64), hh = vtr(vb + c * 16 * VP + 8 * VP + db * 64); \
                const bf16x8 vf = {lo[0], lo[1], lo[2], lo[3], hh[0], hh[1], hh[2], hh[3]}; \
                o[db] = __builtin_amdgcn_mfma_f32_32x32x16_bf16(pa, vf, o[db], 0, 0, 0); } } \
        __builtin_amdgcn_s_setprio(0); \
    } while (0)
#define ATT_VIS(t) (64 * (t) <= qw0 + 31)
    ATT_DMA(0, 0, 0); ATT_BAR();
    int vcur = 0;
#define ATT_VNEXT(v) (((v) == 2) ? 0 : (v) + 1)
    if (!shifted) {
        for (int t = 0; t < NT; ++t) {
            const int vnext = ATT_VNEXT(vcur);
            if (t + 1 < NT) ATT_DMA(t + 1, (t + 1) & 1, vnext);
            if (ATT_VIS(t)) { ATT_A(t); ATT_B(vcur); }
            vcur = vnext;
            ATT_BAR();
        }
    } else {
        int vprev = 2;
        for (int t = 0; t < NT; ++t) {
            const int vnext = ATT_VNEXT(vcur);
            if (t + 1 < NT) ATT_DMA(t + 1, (t + 1) & 1, vnext);
            if (t > 0 && ATT_VIS(t - 1)) ATT_B(vprev);
            if (ATT_VIS(t)) ATT_A(t);
            vprev = vcur; vcur = vnext;
            ATT_BAR();
        }
        if (ATT_VIS(NT - 1)) ATT_B(vprev);
    }
    ATT_BAR();
#undef ATT_DMA
#undef ATT_BAR
#undef ATT_VNEXT
#undef ATT_A
#undef ATT_B
#undef ATT_VIS
    l = xhalf_sum(l);
    if (hi == 0) wsf[32 + r32] = l;
    asm volatile("s_waitcnt lgkmcnt(0)" ::: "memory");
#pragma unroll
    for (int r = 0; r < 16; ++r) rl[r] = 1.0f / wsf[32 + crow(r, hi)];
    asm volatile("s_waitcnt lgkmcnt(0)" ::: "memory");
}
}

constexpr size_t MiB = 1u << 20;
constexpr size_t WS_SSQ = 9 * MiB;
constexpr size_t WS_COS = 1 * MiB, WS_SIN = 5 * MiB;
constexpr size_t WS_O0 = 185 * MiB + 256 * MiB;
constexpr size_t WS_W = 41 * MiB;
constexpr size_t W_GU = (size_t)2 * DFF * DM * 2, W_DN = (size_t)DM * DFF * 2, W_FFN = W_GU + W_DN;
constexpr size_t WS_WFFN = WS_W;
constexpr size_t WS_WDIN = WS_WFFN + 4 * W_FFN, WS_WDOUT = WS_WDIN + (size_t)3072 * 1024 * 2, WS_WMIN = WS_WDOUT + (size_t)1024 * 1024 * 2, WS_WMQ = WS_WMIN + (size_t)768 * 1024 * 2,
                 WS_WMKV = WS_WMQ + (size_t)1536 * 384 * 2, WS_WMOUT = WS_WMKV + (size_t)2048 * 256 * 2, WS_WEND = WS_WMOUT + (size_t)1024 * 1024 * 2;
constexpr size_t WS_XB = 121 * MiB;
constexpr size_t WS_R = 185 * MiB;
constexpr size_t WS_ACT = WS_R;
constexpr size_t WS_DQ = WS_R, WS_DK = WS_R + 64 * MiB, WS_DV = WS_R + 128 * MiB, WS_DAO = WS_R + 192 * MiB;
constexpr size_t WS_MQ = WS_R, WS_MC = WS_R, WS_MK = WS_R + 96 * MiB, WS_MV = WS_R + 192 * MiB, WS_MAO = WS_R + 256 * MiB;
constexpr size_t WS_MCQ = WS_MAO, WS_MCKV = WS_MAO + 24 * MiB;
constexpr size_t WS_END = WS_R + 320 * MiB;
static_assert(WS_WEND <= WS_XB && WS_ACT + (size_t)MTOK * DFF * 2 <= WS_END && WS_END <= 512 * MiB, "workspace map");

#ifndef ATT_REPS
#define ATT_REPS 1
#endif
#ifndef DIFF_REPS
#define DIFF_REPS 1
#endif
constexpr int LDS_BYTES = 147456, XB_LDS_OFF = 131072 + 1024, RTAB_OFF = 131072 + 2048, RTAB_UNITS = 12;
static_assert(RTAB_OFF + RTAB_UNITS * 1024 <= LDS_BYTES, "LDS map");
constexpr size_t WS_PCNT = 16384;
constexpr size_t WS_BAR = 0;

struct WDesc { const float* W; const float* gain; bf16* WT; int K, N, mode, item0; };
constexpr int NWD = 22;
struct Args {
    const float* x; const int* pos;
    const float *lq1, *lk1, *lq2, *lk2, *sub_gain, *mq_norm, *mkv_norm, *final_norm;
    float* out; unsigned char* ws;
    WDesc wd[NWD];
    int nitems, nearly;
};

#define XB_TMO      128
#define XB_XCNT(j)  (256  + 64 * (j))
#define XB_XSUB(j)  (1280 + 64 * (j))
#define XB_XGEN(j)  (2304 + 64 * (j))
#define XB_TOP      3328
#define XB_TOPGEN   3392
#define XCD_BAR_WORDS 3456
#define XB_SPIN_CAP (1u << 18)

__device__ __forceinline__ unsigned xb_ld(unsigned* p)              { return __hip_atomic_load(p, __ATOMIC_RELAXED, __HIP_MEMORY_SCOPE_AGENT); }
__device__ __forceinline__ unsigned xb_add(unsigned* p, unsigned v) { return __hip_atomic_fetch_add(p, v, __ATOMIC_RELAXED, __HIP_MEMORY_SCOPE_AGENT); }
__device__ __forceinline__ unsigned xb_xcc_id() { return (unsigned)__builtin_amdgcn_s_getreg((3 << 11) | 20) & 0xFu; }
#define XB_SPIN(cond, bar) do { unsigned _sp = 0; while (cond) { __builtin_amdgcn_s_sleep(1); \
    if ((++_sp & 255u) == 0u) { if (xb_ld(&(bar)[XB_TMO])) break; if (_sp > XB_SPIN_CAP) { atomicAdd(&(bar)[XB_TMO], 1u); break; } } } } while (0)

struct XcdBarrier {
    unsigned* bar; unsigned x;
    volatile LAS unsigned* st;
};

__device__ __forceinline__ XcdBarrier xcd_barrier_post(unsigned* bar, volatile LAS unsigned* st) {
    XcdBarrier b; b.bar = bar; b.x = xb_xcc_id(); b.st = st;
    if (threadIdx.x == 0) (void)xb_add(&bar[XB_XCNT(b.x)], 1u);
    return b;
}
__device__ __forceinline__ void xcd_barrier_complete(unsigned* bar, unsigned x, unsigned& nloc, unsigned& nx) {
    const unsigned G = gridDim.x * gridDim.y * gridDim.z;
    unsigned sum, cnt, mine, sp = 0u;
    for (;;) {
        sum = 0u; cnt = 0u; mine = 0u;
#pragma unroll
        for (unsigned j = 0; j < 16; ++j) { const unsigned c = xb_ld(&bar[XB_XCNT(j)]); sum += c; cnt += (c > 0u) ? 1u : 0u; mine = (j == x) ? c : mine; }
        if (sum == G) break;
        __builtin_amdgcn_s_sleep(1);
        if ((++sp & 255u) == 0u) { if (xb_ld(&bar[XB_TMO])) break; if (sp > XB_SPIN_CAP) { atomicAdd(&bar[XB_TMO], 1u); break; } }
    }
    nloc = mine > 0u ? mine : 1u; nx = cnt > 0u ? cnt : 1u;
}

__device__ __forceinline__ void xcd_barrier(const XcdBarrier& b) {
    asm volatile("s_waitcnt vmcnt(0)" ::: "memory");
    __syncthreads();
    if (threadIdx.x == 0) {
        unsigned* bar = b.bar;
        __builtin_amdgcn_s_waitcnt(0);
        unsigned nloc = b.st[0], nx = b.st[1];
        if (nloc == 0u) { xcd_barrier_complete(bar, b.x, nloc, nx); b.st[0] = nloc; b.st[1] = nx; }
        const unsigned old = xb_add(&bar[XB_XSUB(b.x)], 1u);
        const unsigned gen = old / nloc;
        if (old + 1u == (gen + 1u) * nloc) {
            __builtin_amdgcn_fence(__ATOMIC_RELEASE, "agent");
            asm volatile("s_waitcnt vmcnt(0)" ::: "memory");
            const unsigned og = xb_add(&bar[XB_TOP], 1u);
            const unsigned tg = og / nx;
            if (og + 1u == (tg + 1u) * nx) xb_add(&bar[XB_TOPGEN], 1u);
            else XB_SPIN(xb_ld(&bar[XB_TOPGEN]) == tg, bar);
            __builtin_amdgcn_fence(__ATOMIC_ACQUIRE, "agent");
            xb_add(&bar[XB_XGEN(b.x)], 1u);
            asm volatile("s_waitcnt vmcnt(0)" ::: "memory");
        } else {
            XB_SPIN(xb_ld(&bar[XB_XGEN(b.x)]) == gen, bar);
            __builtin_amdgcn_fence(__ATOMIC_ACQUIRE, "agent");
            asm volatile("s_waitcnt vmcnt(0)" ::: "memory");
        }
    }
    __syncthreads();
}

__device__ __forceinline__ int wmap(int mode, int n) {
    switch (mode) {
        case 1: return 256 * (n >> 7) + (n & 127);
        case 2: return 256 * (n >> 7) + 128 + (n & 127);
        case 3: { if (n >= 2048) return n; const int chunk = n >> 6, half = (n >> 5) & 1, i = n & 31; return 256 * (chunk >> 2) + 128 * half + 32 * (chunk & 3) + i; }
        case 4: { const int h = n / 192, j = n - 192 * h; if (j < 128) return h * 128 + j; const int i = j - 128, half = i >> 5, ii = i & 31; return 1024 + 256 * (h >> 2) + 128 * half + 32 * (h & 3) + ii; }
        case 5: { if (n < 608) return n; if (n < 640) return n + 32; if (n < 672) return n - 32; return n + 64; }
        default: return n;
    }
}
__device__ __forceinline__ void tr_load(float (&wv)[32], const float* W, int N, int nblk, int item, int lane) {
    const int kb = item / nblk, nb = item - kb * nblk, k0 = 64 * kb, n0 = 32 * nb;
#pragma unroll
    for (int i = 0; i < 32; ++i) wv[i] = __builtin_nontemporal_load(&W[(size_t)(k0 + 2 * i + (lane >> 5)) * N + n0 + (lane & 31)]);
}
__device__ __forceinline__ void tr_store(const float (&wv)[32], const float* gain, int K, int nblk, bf16* WT, int mode, LAS float* scr, int item, int lane) {
    const int kb = item / nblk, nb = item - kb * nblk, k0 = 64 * kb, n0 = 32 * nb;
    f32x4 g0 = {1.f, 1.f, 1.f, 1.f}, g1 = g0;
    if (gain) { g0 = *(const f32x4*)(gain + k0 + 8 * (lane & 7)); g1 = *(const f32x4*)(gain + k0 + 8 * (lane & 7) + 4); }
#pragma unroll
    for (int i = 0; i < 32; ++i) scr[(2 * i + (lane >> 5)) * 33 + (lane & 31)] = wv[i];
    asm volatile("s_waitcnt lgkmcnt(0)" ::: "memory");
    const int c = lane & 7;
#pragma unroll
    for (int j = 0; j < 4; ++j) { const int n = (lane >> 3) + 8 * j; const LAS float* sp = scr + (8 * c) * 33 + n;
        v4u o; o.x = pk2(sp[0 * 33] * g0[0], sp[1 * 33] * g0[1]); o.y = pk2(sp[2 * 33] * g0[2], sp[3 * 33] * g0[3]); o.z = pk2(sp[4 * 33] * g1[0], sp[5 * 33] * g1[1]); o.w = pk2(sp[6 * 33] * g1[2], sp[7 * 33] * g1[3]);
        *(v4u*)(WT + (size_t)wmap(mode, n0 + n) * K + k0 + 8 * c) = o; }
    asm volatile("s_waitcnt lgkmcnt(0)" ::: "memory");
}

__global__ void __launch_bounds__(NWAVES * 64, 2) fwd_kernel(Args args) {
    extern __shared__ __attribute__((aligned(16))) unsigned char lds_raw[];
    LAS unsigned char* lds = (LAS unsigned char*)lds_raw;
    cg::grid_group cgrid = cg::this_grid();
    if (threadIdx.x < 2) ((volatile LAS unsigned*)(lds + XB_LDS_OFF))[threadIdx.x] = 0u;
    __syncthreads();
    XcdBarrier xbar;
    struct GridSeam { XcdBarrier* b; __device__ __forceinline__ void sync() const { xcd_barrier(*b); } } grid{&xbar};
    const int G = gridDim.x, bx = blockIdx.x;
    const int vcu = (G % 8 == 0) ? (bx % 8) * (G / 8) + bx / 8 : bx;
    const int NGW = G * NWAVES;
#define PHASE_IDS() int tid = threadIdx.x; asm volatile("" : "+v"(tid)); const int lane = tid & 63, wave = __builtin_amdgcn_readfirstlane(tid >> 6); const int gw = vcu * NWAVES + wave; (void)lane; (void)gw
    unsigned char* ws = args.ws;
    float* ssq = (float*)(ws + WS_SSQ);
    float* cosT = (float*)(ws + WS_COS); float* sinT = (float*)(ws + WS_SIN);
    bf16* XB = (bf16*)(ws + WS_XB);
    float* X = args.out;

    {
        PHASE_IDS();
        LAS float* scr = (LAS float*)(lds + wave * 16384);
#define PRO_FIND(g, mi_) do { mi_ = 0; for (int j_ = 1; j_ < NWD; ++j_) if ((g) >= args.wd[j_].item0) mi_ = j_; } while (0)
#define PRO_LOAD(wv_, g) do { int mi_; PRO_FIND(g, mi_); const int N_ = args.wd[mi_].N; tr_load(wv_, args.wd[mi_].W, N_, N_ / 32, (g) - args.wd[mi_].item0, lane); } while (0)
#define PRO_STORE(wv_, g) do { int mi_; PRO_FIND(g, mi_); tr_store(wv_, args.wd[mi_].gain, args.wd[mi_].K, args.wd[mi_].N / 32, args.wd[mi_].WT, args.wd[mi_].mode, scr, (g) - args.wd[mi_].item0, lane); } while (0)
        {
            const int total = args.nearly; float wa[32], wb[32];
            int g = gw;
            if (g < total) {
                PRO_LOAD(wa, g);
                for (;;) {
                    const bool n1 = g + NGW < total;
                    if (n1) PRO_LOAD(wb, g + NGW);
                    PRO_STORE(wa, g);
                    if (!n1) break;
                    g += NGW;
                    const bool n2 = g + NGW < total;
                    if (n2) PRO_LOAD(wa, g + NGW);
                    PRO_STORE(wb, g);
                    if (!n2) break;
                    g += NGW;
                }
            }
        }
        { v4u* z = (v4u*)(ws + WS_WMIN + (size_t)672 * 1024 * 2); const int nz = 64 * 1024 * 2 / 16; for (int i = bx * 512 + tid; i < nz; i += G * 512) z[i] = (v4u){0u, 0u, 0u, 0u}; }
        for (int i = bx * 512 + tid; i < MTOK * 32; i += G * 512) { const int row = i >> 5, fi = i & 31; const float inv = exp2f(-(float)fi * (13.287712379549449f / 32.0f)); const float ang = (float)args.pos[row] * inv; float sv, cv; sincosf(ang, &sv, &cv); cosT[i] = cv; sinT[i] = sv; }
        if (bx == 0) for (int i = tid; i < XCD_BAR_WORDS; i += 512) ((unsigned*)(ws + WS_BAR))[i] = 0u;
        if (bx == 1 % G) for (int i = tid; i < 128 * 64; i += 512) ((unsigned*)(ws + WS_PCNT))[i] = 0u;
        for (int mrow0 = gw; mrow0 < MTOK; mrow0 += 2 * NGW) {
            const bool two = mrow0 + NGW < MTOK; const int mrow1 = two ? mrow0 + NGW : mrow0;
            f32x4 va[4], vb[4];
#pragma unroll
            for (int j = 0; j < 4; ++j) { va[j] = __builtin_nontemporal_load(((const f32x4*)(args.x + (size_t)mrow0 * DM) + lane) + 64 * j); vb[j] = __builtin_nontemporal_load(((const f32x4*)(args.x + (size_t)mrow1 * DM) + lane) + 64 * j); }
#pragma unroll
            for (int rr = 0; rr < 2; ++rr) { if (rr == 1 && !two) break; const int mrow = rr ? mrow1 : mrow0; float s = 0.f; unsigned long long* o8 = (unsigned long long*)(XB + (size_t)mrow * DM) + lane;
#pragma unroll
                for (int j = 0; j < 4; ++j) { const f32x4 v = rr ? vb[j] : va[j]; const unsigned w0 = pk2(v.x, v.y), w1 = pk2(v.z, v.w); o8[64 * j] = (unsigned long long)w0 | ((unsigned long long)w1 << 32);
                    const float r0 = __uint_as_float(w0 << 16), r1 = __uint_as_float(w0 & 0xffff0000u), r2 = __uint_as_float(w1 << 16), r3 = __uint_as_float(w1 & 0xffff0000u); s += (r0 * r0 + r1 * r1) + (r2 * r2 + r3 * r3); }
                s = wave_sum(s); if (lane < 16) ssq[(size_t)mrow * 16 + lane] = (lane == 0) ? s : 0.f; }
        }
    }
    cgrid.sync();
    xbar = xcd_barrier_post((unsigned*)(ws + WS_BAR), (volatile LAS unsigned*)(lds + XB_LDS_OFF));

    const float C2_DIFF = 0.125f * 1.4426950408889634f;
    const float C2_MLA = 0.07216878364870322f * 1.4426950408889634f;

#define FFN_PHASES(widx, ssq_in, ssq_out) do { \
        { pg8::Gemm g{XB, (const bf16*)(ws + WS_WFFN + (size_t)(widx) * W_FFN), MTOK, 2 * DFF, DM}; pg8::StaticOrder S; S.init(MTOK, 2 * DFF, G, bx); \
          pg8::rstd_table_fill<0>((LAS float*)(lds + RTAB_OFF), S, ssq + (size_t)(ssq_in) * MTOK * 16, RTAB_UNITS); \
          pg8::EpiSwiglu E{(bf16*)(ws + WS_ACT), DFF, (const LAS float*)(lds + RTAB_OFF), 0}; \
          pg8::gemm_phase<pg8::EpiSwiglu, pg8::StaticOrder, true, true>(lds, g, S, E); } \
        grid.sync(); \
        { pg8::Gemm g{(const bf16*)(ws + WS_ACT), (const bf16*)(ws + WS_WFFN + (size_t)(widx) * W_FFN + W_GU), MTOK, DM, DFF}; pg8::StaticOrder S; S.init(MTOK, DM, G, bx); \
          pg8::EpiResid E{XB, ssq + (size_t)(ssq_out) * MTOK * 16, 0.5f}; \
          pg8::gemm_phase<pg8::EpiResid, pg8::StaticOrder, true, true, 2>(lds, g, S, E); } \
        grid.sync(); } while (0)

    FFN_PHASES(0, 0, 1);
    { pg8::Gemm g{XB, (const bf16*)(ws + WS_WDIN), MTOK, 3072, DM}; pg8::StaticOrder S; S.init(MTOK, 3072, G, bx);
      pg8::rstd_table_fill<0>((LAS float*)(lds + RTAB_OFF), S, ssq + (size_t)1 * MTOK * 16, RTAB_UNITS);
      pg8::EpiDiffQKV E{(bf16*)(ws + WS_DQ), (bf16*)(ws + WS_DK), (bf16*)(ws + WS_DV), (const LAS float*)(lds + RTAB_OFF), cosT, sinT, C2_DIFF, 0};
      pg8::gemm_phase<pg8::EpiDiffQKV, pg8::StaticOrder, true, true>(lds, g, S, E); }
    grid.sync();
    {
        PHASE_IDS();
        float lam;
        { float a = 0.f, b = 0.f; for (int i = 0; i < 64; ++i) { a += args.lq1[i] * args.lk1[i]; b += args.lq2[i] * args.lk2[i]; } lam = expf(a) - expf(b) + 0.2f; }
        const float post = 1.0f - 0.2f;
        const bf16* Qd = (const bf16*)(ws + WS_DQ); const bf16* Kd = (const bf16*)(ws + WS_DK); const bf16* Vd = (const bf16*)(ws + WS_DV); bf16* AO = (bf16*)(ws + WS_DAO);
        LAS float* scr = (LAS float*)(lds + wave * 16384);
        float wvl[32]; int late_g = args.nearly + gw; bool late_have = late_g < args.nitems;
        if (late_have) PRO_LOAD(wvl, late_g);
#define LATE_STEP() do { if (late_have) { PRO_STORE(wvl, late_g); late_g += NGW; late_have = late_g < args.nitems; if (late_have) PRO_LOAD(wvl, late_g); } __syncthreads(); } while (0)
        for (int rep = 0; rep < DIFF_REPS; ++rep)
        for (int pi = vcu; pi < 512; pi += G) {
            const int bh = pi >> 3, s8 = pi & 7, b = bh >> 3, h = bh & 7;
            for (int half = 0; half < 2; ++half) {
                const int qb = half ? 15 - s8 : s8;
                att::f32x16 o[4]; float rl[16];
                const size_t rb = (size_t)b * SEQ * 1024;
                att::attn_pass4<64>(lds, Qd + rb + (2 * h) * 64, 1024, Kd + rb + (2 * h) * 64, 1024, Vd + rb + h * 128, 1024, qb * 256, o, rl);
                LATE_STEP();
                int t1 = threadIdx.x; asm volatile("" : "+v"(t1));
                f32x4* scrO = (f32x4*)((float*)(ws + WS_O0) + ((size_t)bx * 512 + t1) * 64);
#pragma unroll
                for (int db = 0; db < 4; ++db)
#pragma unroll
                    for (int r4 = 0; r4 < 4; ++r4) scrO[db * 4 + r4] = (f32x4){o[db][4 * r4] * rl[4 * r4], o[db][4 * r4 + 1] * rl[4 * r4 + 1], o[db][4 * r4 + 2] * rl[4 * r4 + 2], o[db][4 * r4 + 3] * rl[4 * r4 + 3]};
                att::attn_pass4<64>(lds, Qd + rb + (2 * h + 1) * 64, 1024, Kd + rb + (2 * h + 1) * 64, 1024, Vd + rb + h * 128, 1024, qb * 256, o, rl);
                LATE_STEP();
                int t2 = threadIdx.x; asm volatile("" : "+v"(t2));
                const int r32 = t2 & 31, hi = (t2 >> 5) & 1; const size_t row0 = (size_t)b * SEQ + qb * 256 + (t2 >> 6) * 32;
                scrO = (f32x4*)((float*)(ws + WS_O0) + ((size_t)bx * 512 + t2) * 64);
                float g4[4];
#pragma unroll
                for (int db = 0; db < 4; ++db) g4[db] = args.sub_gain[32 * db + r32] * post;
#pragma unroll
                for (int r = 0; r < 16; ++r) {
                    float v[4], sq = 0.f;
#pragma unroll
                    for (int db = 0; db < 4; ++db) { v[db] = ((const float*)scrO)[db * 16 + r] - lam * o[db][r] * rl[r]; sq += v[db] * v[db]; }
                    sq += __shfl_xor(sq, 1); sq += __shfl_xor(sq, 2); sq += __shfl_xor(sq, 4); sq += __shfl_xor(sq, 8); sq += __shfl_xor(sq, 16);
                    const float rs = rsqrtf(sq * (1.0f / 128.0f) + 1e-6f);
                    bf16* orow = AO + (row0 + att::crow(r, hi)) * 1024 + h * 128 + r32;
#pragma unroll
                    for (int db = 0; db < 4; ++db) orow[32 * db] = (bf16)f2bf(v[db] * rs * g4[db]);
                }
            }
        }
        while (late_have) { PRO_STORE(wvl, late_g); late_g += NGW; late_have = late_g < args.nitems; if (late_have) PRO_LOAD(wvl, late_g); }
#undef LATE_STEP
#undef PRO_FIND
#undef PRO_LOAD
#undef PRO_STORE
    }
    grid.sync();
    { pg8::Gemm g{(const bf16*)(ws + WS_DAO), (const bf16*)(ws + WS_WDOUT), MTOK, DM, DM}; pg8::StaticOrder S; S.init(MTOK, DM, G, bx);
      pg8::EpiResid E{XB, ssq + (size_t)2 * MTOK * 16, 1.0f};
      pg8::gemm_phase<pg8::EpiResid, pg8::StaticOrder, true, true>(lds, g, S, E); }
    grid.sync();
    FFN_PHASES(1, 2, 3);

    FFN_PHASES(2, 3, 4);
    { pg8::Gemm g{XB, (const bf16*)(ws + WS_WMIN), MTOK, 768, DM}; pg8::StaticOrder S; S.init(MTOK, 768, G, bx);
      pg8::rstd_table_fill<0>((LAS float*)(lds + RTAB_OFF), S, ssq + (size_t)4 * MTOK * 16, RTAB_UNITS);
      pg8::EpiMlaIn E{(bf16*)(ws + WS_MCQ), (bf16*)(ws + WS_MCKV), (bf16*)(ws + WS_MK), ssq + (size_t)7 * MTOK * 16, (const LAS float*)(lds + RTAB_OFF), cosT, sinT, 0};
      pg8::gemm_phase<pg8::EpiMlaIn, pg8::StaticOrder, true, true>(lds, g, S, E); }
    grid.sync();
    { pg8::Gemm g{(const bf16*)(ws + WS_MCQ), (const bf16*)(ws + WS_WMQ), MTOK, 1536, 384}; pg8::StaticOrder S; S.init(MTOK, 1536, G, bx);
      pg8::rstd_table_fill<1>((LAS float*)(lds + RTAB_OFF), S, ssq + (size_t)7 * MTOK * 16, RTAB_UNITS);
      pg8::EpiMlaQ E{(bf16*)(ws + WS_MQ), cosT, sinT, (const LAS float*)(lds + RTAB_OFF), C2_MLA, 0};
      pg8::gemm_phase<pg8::EpiMlaQ, pg8::StaticOrder, true, true>(lds, g, S, E); }
    { pg8::Gemm g{(const bf16*)(ws + WS_MCKV), (const bf16*)(ws + WS_WMKV), MTOK, 2048, 256}; pg8::StaticOrder S; S.init(MTOK, 2048, G, bx);
      pg8::rstd_table_fill<2>((LAS float*)(lds + RTAB_OFF), S, ssq + (size_t)7 * MTOK * 16, RTAB_UNITS);
      pg8::EpiMlaKV E{(bf16*)(ws + WS_MK), (bf16*)(ws + WS_MV), (const LAS float*)(lds + RTAB_OFF), 0};
      pg8::gemm_phase<pg8::EpiMlaKV, pg8::StaticOrder, true, true>(lds, g, S, E); }
    grid.sync();
    {
        PHASE_IDS();
        const bf16* Qm = (const bf16*)(ws + WS_MQ); const bf16* Km = (const bf16*)(ws + WS_MK); const bf16* Vm = (const bf16*)(ws + WS_MV); bf16* AO = (bf16*)(ws + WS_MAO);
        for (int rep = 0; rep < ATT_REPS; ++rep)
        for (int pi = vcu; pi < 512; pi += G) {
            const int bh = pi >> 3, s8 = pi & 7, b = bh >> 3, h = bh & 7;
            for (int half = 0; half < 2; ++half) {
                const int qb = half ? 15 - s8 : s8;
                att::f32x16 o[4]; float rl[16];
                att::attn_pass4<192>(lds, Qm + (size_t)b * SEQ * 1536 + h * 192, 1536, Km + (size_t)b * SEQ * 1536 + h * 192, 1536, Vm + (size_t)b * SEQ * 1024 + h * 128, 1024, qb * 256, o, rl);
                int t2 = threadIdx.x; asm volatile("" : "+v"(t2));
                const int r32 = t2 & 31, hi = (t2 >> 5) & 1; const size_t row0 = (size_t)b * SEQ + qb * 256 + (t2 >> 6) * 32;
#pragma unroll
                for (int r = 0; r < 16; ++r) { bf16* orow = AO + (row0 + att::crow(r, hi)) * 1024 + h * 128 + r32;
#pragma unroll
                    for (int db = 0; db < 4; ++db) orow[32 * db] = (bf16)f2bf(o[db][r] * rl[r]); }
            }
        }
    }
    grid.sync();
    { pg8::Gemm g{(const bf16*)(ws + WS_MAO), (const bf16*)(ws + WS_WMOUT), MTOK, DM, DM}; pg8::StaticOrder S; S.init(MTOK, DM, G, bx);
      pg8::EpiResid E{XB, ssq + (size_t)5 * MTOK * 16, 1.0f};
      pg8::gemm_phase<pg8::EpiResid, pg8::StaticOrder, true, true>(lds, g, S, E); }
    grid.sync();
    if (G == 256) {
        { pg8::Gemm g{XB, (const bf16*)(ws + WS_WFFN + (size_t)3 * W_FFN), MTOK, 2 * DFF, DM}; pg8::StaticOrder S; S.init(MTOK, 2 * DFF, G, bx);
          pg8::rstd_table_fill<0>((LAS float*)(lds + RTAB_OFF), S, ssq + (size_t)5 * MTOK * 16, RTAB_UNITS);
          pg8::EpiSwiglu E{(bf16*)(ws + WS_ACT), DFF, (const LAS float*)(lds + RTAB_OFF), 0};
          pg8::gemm_phase<pg8::EpiSwiglu, pg8::StaticOrder, true, true>(lds, g, S, E); }
        grid.sync();
        { pg8::Gemm g{(const bf16*)(ws + WS_ACT), (const bf16*)(ws + WS_WFFN + (size_t)3 * W_FFN + W_GU), MTOK, DM, DFF}; pg8::StaticOrder S; S.init(MTOK, DM, G, bx);
          pg8::EpiResidFinal E{XB, ssq + (size_t)6 * MTOK * 16, X, args.final_norm, (unsigned*)(ws + WS_PCNT), (LAS float*)(lds + RTAB_OFF), 0.5f};
          pg8::gemm_phase<pg8::EpiResidFinal, pg8::StaticOrder, true, true, 2>(lds, g, S, E); }
    } else {
    FFN_PHASES(3, 5, 6);


    PHASE_IDS();
    for (int mrow0 = gw; mrow0 < MTOK; mrow0 += 2 * NGW) {
        const bool two = mrow0 + NGW < MTOK; const int mrow1 = two ? mrow0 + NGW : mrow0;
        unsigned long long wa[4], wb[4];
#pragma unroll
        for (int j = 0; j < 4; ++j) { wa[j] = ((const unsigned long long*)(XB + (size_t)mrow0 * DM) + lane)[64 * j]; wb[j] = ((const unsigned long long*)(XB + (size_t)mrow1 * DM) + lane)[64 * j]; }
        const float ra = pg8::rstd1024(ssq + (size_t)6 * MTOK * 16, mrow0), rb = pg8::rstd1024(ssq + (size_t)6 * MTOK * 16, mrow1);
#pragma unroll
        for (int rr = 0; rr < 2; ++rr) { if (rr == 1 && !two) break; const int mrow = rr ? mrow1 : mrow0; const float r = rr ? rb : ra; f32x4* orow = (f32x4*)(X + (size_t)mrow * DM) + lane;
#pragma unroll
            for (int j = 0; j < 4; ++j) { const unsigned long long w = rr ? wb[j] : wa[j]; const unsigned w0 = (unsigned)w, w1 = (unsigned)(w >> 32); const f32x4 gn = *((const f32x4*)args.final_norm + lane + 64 * j);
                f32x4 v; v.x = __uint_as_float(w0 << 16); v.y = __uint_as_float(w0 & 0xffff0000u); v.z = __uint_as_float(w1 << 16); v.w = __uint_as_float(w1 & 0xffff0000u);
                orow[64 * j] = v * r * gn; } }
    }
    }
#undef FFN_PHASES
}

extern "C" void kernel_launch(void* const* d_in, const int* in_sizes, int n_in, void* d_out, int out_size, void* d_ws, size_t ws_size, hipStream_t stream) {
    static int grid = 0;
    if (grid == 0) {
        if (n_in != 25 || out_size != MTOK * DM || ws_size < WS_END) { fprintf(stderr, "kernel_launch: unexpected shapes (n_in %d, out %d, ws %zu)\n", n_in, out_size, ws_size); grid = -1; return; }
        int dev = 0, cus = 0, per_cu = 0;
        hipGetDevice(&dev); hipDeviceGetAttribute(&cus, hipDeviceAttributeMultiprocessorCount, dev);
        hipFuncSetAttribute((const void*)fwd_kernel, hipFuncAttributeMaxDynamicSharedMemorySize, LDS_BYTES);
        hipOccupancyMaxActiveBlocksPerMultiprocessor(&per_cu, (const void*)fwd_kernel, NWAVES * 64, LDS_BYTES);
        if (per_cu < 1) per_cu = 1;
        (void)hipGetLastError();
        grid = cus;
        fprintf(stderr, "kernel_launch: cus %d per_cu %d grid %d\n", cus, per_cu, grid);
    }
    if (grid < 0) return;
    Args a{};
    const float* const* in = (const float* const*)d_in;
    a.x = in[0]; a.pos = (const int*)d_in[1];
    a.lq1 = in[12]; a.lk1 = in[13]; a.lq2 = in[14]; a.lk2 = in[15]; a.sub_gain = in[16]; a.mq_norm = in[19]; a.mkv_norm = in[21]; a.final_norm = in[24];
    a.out = (float*)d_out; a.ws = (unsigned char*)d_ws;
    unsigned char* ws = (unsigned char*)d_ws;
    int nd = 0, items = 0;
    auto add = [&](const float* W, const float* gain, size_t wt_off, int K, int N, int mode) { WDesc& d = a.wd[nd++]; d.W = W; d.gain = gain; d.WT = (bf16*)(ws + wt_off); d.K = K; d.N = N; d.mode = mode; d.item0 = items; items += (K / 64) * (N / 32); };
    auto add_ffn = [&](int l, int f) { const int base = f ? 7 : 2; const size_t wo = WS_WFFN + (size_t)(l * 2 + f) * W_FFN; const float* gain = in[base] + (size_t)l * DM;
        add(in[base + 1] + (size_t)l * DM * DFF, gain, wo, DM, DFF, 1); add(in[base + 2] + (size_t)l * DM * DFF, gain, wo, DM, DFF, 2); add(in[base + 3] + (size_t)l * DFF * DM, nullptr, wo + W_GU, DFF, DM, 0); };
    add_ffn(0, 0);
    add(in[11], in[6], WS_WDIN, DM, 3072, 3);
    a.nearly = items;
    add(in[17], nullptr, WS_WDOUT, DM, DM, 0);
    add_ffn(0, 1); add_ffn(1, 0);
    add(in[18], in[6] + DM, WS_WMIN, DM, 704, 5);
    add(in[20], in[19], WS_WMQ, 384, 1536, 4);
    add(in[22], in[21], WS_WMKV, 256, 2048, 0);
    add(in[23], nullptr, WS_WMOUT, DM, DM, 0);
    add_ffn(1, 1);
    for (; nd < NWD; ) { WDesc& d = a.wd[nd++]; d.W = in[23]; d.gain = nullptr; d.WT = (bf16*)(ws + WS_WMOUT); d.K = 0; d.N = 32; d.mode = 0; d.item0 = 0x7fffffff; }
    a.nitems = items;
    void* kargs[] = {&a};
    hipError_t e = hipLaunchCooperativeKernel((const void*)fwd_kernel, dim3(grid), dim3(NWAVES * 64), kargs, LDS_BYTES, stream);
    if (e != hipSuccess) fprintf(stderr, "cooperative launch failed: %s (grid %d)\n", hipGetErrorString(e), grid);
}
```

```cpp
#include <hip/hip_runtime.h>
#include <hip/hip_cooperative_groups.h>
#include <cstdio>
#include <cstdint>
#include <cmath>
namespace cg = cooperative_groups;
namespace pg8 {
#define PG8_LAS __attribute__((address_space(3)))
typedef unsigned short bf16_t;
typedef short bf16x8 __attribute__((ext_vector_type(8)));
typedef float f32x4 __attribute__((ext_vector_type(4)));
typedef unsigned u32x4 __attribute__((ext_vector_type(4)));
constexpr int BM = 256, BK = 64, HALF = 128, HTB = HALF * BK * 2  , STAGE_BYTES = 8 * HTB, NXCD = 8, WGM = 8;

__host__ __device__ __forceinline__ int lds_byte(int r, int c) { const int st = (r >> 4) * 2 + (c >> 5), rr = r & 15, cc = c & 31, ob = rr * 64 + cc * 2; return st * 1024 + (ob ^ (((ob >> 9) & 1) << 5)); }
__host__ __device__ __forceinline__ void stage_rc(int b, int& R, int& C) { const int st = b / 1024, sb = b % 1024, swz = sb ^ (((sb >> 9) & 1) << 5); R = (st >> 1) * 16 + swz / 64; C = (st & 1) * 32 + (swz % 64) / 2; }
__host__ __device__ __forceinline__ int perm32(int rho) { const int n = rho >> 4, i = rho & 15; return 8 * (i >> 2) + 4 * n + (i & 3); }

struct Unit { int pm, pn; };
struct Gemm { const bf16_t* A; const bf16_t* Bt; int M, N, K; };

struct StaticOrder {
    int nM, nN, nwg, G, c;
    __host__ __device__ void init(int M, int N, int G_, int c_) { nM = M / BM; nN = N / BM; nwg = nM * nN; G = G_; c = c_; }
    __host__ __device__ bool next(int i, Unit& u) const {
        const long L = (long)i * G + c; if (L >= nwg) return false;
        int wgid = (int)L; { const int q = nwg / NXCD, r = nwg % NXCD, xcd = wgid % NXCD, off = wgid / NXCD; wgid = (xcd < r ? xcd * (q + 1) : r * (q + 1) + (xcd - r) * q) + off; }
        const int nig = WGM * nN, gid = wgid / nig, fm = gid * WGM, gsz = (nM - fm) < WGM ? (nM - fm) : WGM;
        u.pm = fm + ((wgid % nig) % gsz); u.pn = (wgid % nig) / gsz; return true;
    }
    __device__ __forceinline__ void a_ready(const Unit&) const {}
    __device__ __forceinline__ void done(const Unit&) const {}
};

__device__ __forceinline__ unsigned cvt_pk_bf16(float lo, float hi) { unsigned r; asm volatile("v_cvt_pk_bf16_f32 %0, %1, %2" : "=v"(r) : "v"(lo), "v"(hi)); return r; }
typedef float f32x2 __attribute__((ext_vector_type(2)));
constexpr float NORM_EPS = 1e-6f;
__device__ __forceinline__ float rstd1024(const float* ssq, int row) { const f32x4* p = (const f32x4*)(ssq + (size_t)row * 16); const f32x4 a = p[0], b = p[1], c = p[2], d = p[3];
    const float s = (((a[0] + a[1]) + (a[2] + a[3])) + ((b[0] + b[1]) + (b[2] + b[3]))) + (((c[0] + c[1]) + (c[2] + c[3])) + ((d[0] + d[1]) + (d[2] + d[3]))); return rsqrtf(s * (1.0f / 1024.0f) + NORM_EPS); }
__device__ __forceinline__ unsigned cvt2(float lo, float hi) { typedef float f2 __attribute__((ext_vector_type(2))); typedef __bf16 b2 __attribute__((ext_vector_type(2))); f2 v = {lo, hi}; b2 b = __builtin_convertvector(v, b2); return __builtin_bit_cast(unsigned, b); }
__device__ __forceinline__ u32x4 pack8(const f32x4 a, const f32x4 b) { u32x4 w; w.x = cvt2(a[0], a[1]); w.y = cvt2(a[2], a[3]); w.z = cvt2(b[0], b[1]); w.w = cvt2(b[2], b[3]); return w; }
__device__ __forceinline__ float silu_mul(float g, float u) { return g * __builtin_amdgcn_rcpf(1.0f + __builtin_amdgcn_exp2f(-1.4426950408889634f * g)) * u; }

struct EpiSwiglu {
    static constexpr bool PERM = true, AFTER_DRAIN = false;
    bf16_t* O; int ldo; const PG8_LAS float* rtab; mutable int ui;
    __device__ __forceinline__ void operator()(const f32x4 (&acc)[2][2][4][2], const Unit& u, int wr, int wc, int fr, int fq) const {
        const PG8_LAS float* rt = rtab + ui * 256 + wr * 64 + fr; ++ui;
        const int row0 = u.pm * BM + wr * 64 + fr; const int col0 = u.pn * HALF + wc * 32 + 8 * fq;
#pragma unroll
        for (int ai = 0; ai < 2; ++ai)
#pragma unroll
            for (int m = 0; m < 4; ++m) { const int row = row0 + ai * HALF + m * 16; const float r = rt[ai * HALF + m * 16]; const float r2 = -1.4426950408889634f * r, rr = r * r;
                f32x4 v[2];
#pragma unroll
                for (int n = 0; n < 2; ++n)
#pragma unroll
                    for (int j = 0; j < 4; ++j) { const float g = acc[ai][0][m][n][j], uu = acc[ai][1][m][n][j]; v[n][j] = (g * uu) * (rr * __builtin_amdgcn_rcpf(1.0f + __builtin_amdgcn_exp2f(g * r2))); }
                *(u32x4*)(O + (size_t)row * ldo + col0) = pack8(v[0], v[1]); }
    }
};

struct EpiResid {
    static constexpr bool PERM = true, AFTER_DRAIN = false;
    bf16_t* xb; float* ssq; float scale;
    __device__ __forceinline__ void operator()(const f32x4 (&acc)[2][2][4][2], const Unit& u, int wr, int wc, int fr, int fq) const {
        const int row0 = u.pm * BM + wr * 64 + fr; const int col0 = u.pn * BM + wc * 32 + 8 * fq;
        u32x4 xw[2][4][2];
#pragma unroll
        for (int ai = 0; ai < 2; ++ai)
#pragma unroll
            for (int m = 0; m < 4; ++m)
#pragma unroll
                for (int bj = 0; bj < 2; ++bj) xw[ai][m][bj] = *(const u32x4*)(xb + (size_t)(row0 + ai * HALF + m * 16) * 1024 + col0 + bj * HALF);
#pragma unroll
        for (int ai = 0; ai < 2; ++ai)
#pragma unroll
            for (int m = 0; m < 4; ++m) { const int row = row0 + ai * HALF + m * 16; bf16_t* p = xb + (size_t)row * 1024 + col0; float s = 0.f;
#pragma unroll
                for (int bj = 0; bj < 2; ++bj) { const u32x4 x4 = xw[ai][m][bj]; f32x4 v0, v1;
                    v0[0] = __uint_as_float(x4.x << 16); v0[1] = __uint_as_float(x4.x & 0xffff0000u); v0[2] = __uint_as_float(x4.y << 16); v0[3] = __uint_as_float(x4.y & 0xffff0000u);
                    v1[0] = __uint_as_float(x4.z << 16); v1[1] = __uint_as_float(x4.z & 0xffff0000u); v1[2] = __uint_as_float(x4.w << 16); v1[3] = __uint_as_float(x4.w & 0xffff0000u);
                    v0 = v0 + acc[ai][bj][m][0] * scale; v1 = v1 + acc[ai][bj][m][1] * scale;
                    const u32x4 w = pack8(v0, v1); *(u32x4*)(p + bj * HALF) = w;
                    const float r0 = __uint_as_float(w.x << 16), r1 = __uint_as_float(w.x & 0xffff0000u), r2 = __uint_as_float(w.y << 16), r3 = __uint_as_float(w.y & 0xffff0000u);
                    const float r4 = __uint_as_float(w.z << 16), r5 = __uint_as_float(w.z & 0xffff0000u), r6 = __uint_as_float(w.w << 16), r7 = __uint_as_float(w.w & 0xffff0000u);
                    s += ((r0 * r0 + r1 * r1) + (r2 * r2 + r3 * r3)) + ((r4 * r4 + r5 * r5) + (r6 * r6 + r7 * r7)); }
                s += __shfl_xor(s, 16); s += __shfl_xor(s, 32);
                if (fq == 0) ssq[(size_t)row * 16 + u.pn * 4 + wc] = s; }
    }
};

__device__ __forceinline__ float sumsq8(const u32x4 w) {
    const float r0 = __uint_as_float(w.x << 16), r1 = __uint_as_float(w.x & 0xffff0000u), r2 = __uint_as_float(w.y << 16), r3 = __uint_as_float(w.y & 0xffff0000u);
    const float r4 = __uint_as_float(w.z << 16), r5 = __uint_as_float(w.z & 0xffff0000u), r6 = __uint_as_float(w.w << 16), r7 = __uint_as_float(w.w & 0xffff0000u);
    return ((r0 * r0 + r1 * r1) + (r2 * r2 + r3 * r3)) + ((r4 * r4 + r5 * r5) + (r6 * r6 + r7 * r7)); }
struct EpiResidFinal {
    static constexpr bool PERM = true, AFTER_DRAIN = false;
    const bf16_t* xb; float* ssq; float* out; const float* gain; unsigned* cnt; PG8_LAS float* rt; float scale;
    __device__ __forceinline__ void operator()(const f32x4 (&acc)[2][2][4][2], const Unit& u, int wr, int wc, int fr, int fq) const {
        const int row0 = u.pm * BM + wr * 64 + fr; const int col0 = u.pn * BM + wc * 32 + 8 * fq;
        u32x4 xn[2][4][2];
#pragma unroll
        for (int ai = 0; ai < 2; ++ai) {
            u32x4 xw[4][2];
#pragma unroll
            for (int m = 0; m < 4; ++m)
#pragma unroll
                for (int bj = 0; bj < 2; ++bj) xw[m][bj] = *(const u32x4*)(xb + (size_t)(row0 + ai * HALF + m * 16) * 1024 + col0 + bj * HALF);
#pragma unroll
            for (int m = 0; m < 4; ++m) { const int row = row0 + ai * HALF + m * 16; float s = 0.f;
#pragma unroll
                for (int bj = 0; bj < 2; ++bj) { const u32x4 x4 = xw[m][bj]; f32x4 v0, v1;
                    v0[0] = __uint_as_float(x4.x << 16); v0[1] = __uint_as_float(x4.x & 0xffff0000u); v0[2] = __uint_as_float(x4.y << 16); v0[3] = __uint_as_float(x4.y & 0xffff0000u);
                    v1[0] = __uint_as_float(x4.z << 16); v1[1] = __uint_as_float(x4.z & 0xffff0000u); v1[2] = __uint_as_float(x4.w << 16); v1[3] = __uint_as_float(x4.w & 0xffff0000u);
                    v0 = v0 + acc[ai][bj][m][0] * scale; v1 = v1 + acc[ai][bj][m][1] * scale;
                    const u32x4 w = pack8(v0, v1); xn[ai][m][bj] = w; s += sumsq8(w); }
                s += __shfl_xor(s, 16); s += __shfl_xor(s, 32);
                if (fq == 0) __hip_atomic_store(ssq + (size_t)row * 16 + u.pn * 4 + wc, s, __ATOMIC_RELAXED, __HIP_MEMORY_SCOPE_AGENT); }
        }
        asm volatile("s_waitcnt vmcnt(0)" ::: "memory");
        asm volatile("" ::: "memory"); __builtin_amdgcn_s_barrier(); asm volatile("" ::: "memory");
        if (threadIdx.x == 0) {
            unsigned* c = cnt + 64 * u.pm;
            __hip_atomic_fetch_add(c, 1u, __ATOMIC_RELAXED, __HIP_MEMORY_SCOPE_AGENT);
            unsigned sp = 0; while (__hip_atomic_load(c, __ATOMIC_RELAXED, __HIP_MEMORY_SCOPE_AGENT) < 4u && ++sp < (1u << 24)) __builtin_amdgcn_s_sleep(1);
            __builtin_amdgcn_fence(__ATOMIC_ACQUIRE, "agent");
            asm volatile("s_waitcnt vmcnt(0)" ::: "memory");
        }
        asm volatile("" ::: "memory"); __builtin_amdgcn_s_barrier(); asm volatile("" ::: "memory");
        { int t = threadIdx.x; asm volatile("" : "+v"(t)); if (t < 256) rt[t] = rstd1024(ssq, u.pm * BM + t); }
        asm volatile("s_waitcnt lgkmcnt(0)" ::: "memory");
        asm volatile("" ::: "memory"); __builtin_amdgcn_s_barrier(); asm volatile("" ::: "memory");
        f32x4 g[2][2];
#pragma unroll
        for (int bj = 0; bj < 2; ++bj) { g[bj][0] = *(const f32x4*)(gain + col0 + bj * HALF); g[bj][1] = *(const f32x4*)(gain + col0 + bj * HALF + 4); }
#pragma unroll
        for (int ai = 0; ai < 2; ++ai)
#pragma unroll
            for (int m = 0; m < 4; ++m) { const int rl_ = wr * 64 + fr + ai * HALF + m * 16; const float r = rt[rl_]; float* op = out + (size_t)(u.pm * BM + rl_) * 1024 + col0;
#pragma unroll
                for (int bj = 0; bj < 2; ++bj) { const u32x4 x4 = xn[ai][m][bj]; f32x4 v0, v1;
                    v0[0] = __uint_as_float(x4.x << 16); v0[1] = __uint_as_float(x4.x & 0xffff0000u); v0[2] = __uint_as_float(x4.y << 16); v0[3] = __uint_as_float(x4.y & 0xffff0000u);
                    v1[0] = __uint_as_float(x4.z << 16); v1[1] = __uint_as_float(x4.z & 0xffff0000u); v1[2] = __uint_as_float(x4.w << 16); v1[3] = __uint_as_float(x4.w & 0xffff0000u);
                    *(f32x4*)(op + bj * HALF) = v0 * r * g[bj][0]; *(f32x4*)(op + bj * HALF + 4) = v1 * r * g[bj][1]; } }
    }
};

struct EpiDiffQKV {
    static constexpr bool PERM = true, AFTER_DRAIN = false;
    bf16_t *Q, *K, *V; const PG8_LAS float* rtab; const float* cosT; const float* sinT; float qscale; mutable int ui;
    __device__ __forceinline__ void operator()(const f32x4 (&acc)[2][2][4][2], const Unit& u, int wr, int wc, int fr, int fq) const {
        const PG8_LAS float* rt = rtab + ui * 256 + wr * 64 + fr; ++ui;
        const int row0 = u.pm * BM + wr * 64 + fr;
        if (u.pn >= 8) {
            const int col0 = (u.pn - 8) * BM + wc * 32 + 8 * fq;
#pragma unroll
            for (int ai = 0; ai < 2; ++ai)
#pragma unroll
                for (int m = 0; m < 4; ++m) { const int row = row0 + ai * HALF + m * 16; const float r = rt[ai * HALF + m * 16];
#pragma unroll
                    for (int bj = 0; bj < 2; ++bj) *(u32x4*)(V + (size_t)row * 1024 + col0 + bj * HALF) = pack8(acc[ai][bj][m][0] * r, acc[ai][bj][m][1] * r); }
        } else {
            bf16_t* dst = (u.pn < 4) ? Q : K; const float sc = (u.pn < 4) ? qscale : 1.0f; const int col0 = (u.pn & 3) * BM + wc * 64 + 8 * fq;
#pragma unroll
            for (int ai = 0; ai < 2; ++ai) {
                f32x4 cs[4][2][2];
#pragma unroll
                for (int m = 0; m < 4; ++m)
#pragma unroll
                    for (int n = 0; n < 2; ++n) { const size_t ro = (size_t)(row0 + ai * HALF + m * 16) * 32 + 8 * fq + 4 * n; cs[m][n][0] = *(const f32x4*)(cosT + ro); cs[m][n][1] = *(const f32x4*)(sinT + ro); }
#pragma unroll
                for (int m = 0; m < 4; ++m) { const int row = row0 + ai * HALF + m * 16; const float r = rt[ai * HALF + m * 16] * sc;
                    f32x4 o1[2], o2[2];
#pragma unroll
                    for (int n = 0; n < 2; ++n) { const f32x4 c = cs[m][n][0], s = cs[m][n][1];
                        const f32x4 x1 = acc[ai][0][m][n] * r, x2 = acc[ai][1][m][n] * r; o1[n] = x1 * c - x2 * s; o2[n] = x2 * c + x1 * s; }
                    *(u32x4*)(dst + (size_t)row * 1024 + col0) = pack8(o1[0], o1[1]); *(u32x4*)(dst + (size_t)row * 1024 + col0 + 32) = pack8(o2[0], o2[1]); }
            }
        }
    }
};

struct EpiF32 {
    static constexpr bool PERM = false, AFTER_DRAIN = false;
    float* C; int ldc; const PG8_LAS float* rtab; mutable int ui;
    __device__ __forceinline__ void operator()(const f32x4 (&acc)[2][2][4][2], const Unit& u, int wr, int wc, int fr, int fq) const {
        const PG8_LAS float* rt = rtab + ui * 256 + wr * 64 + fr; ++ui;
        const int row0 = u.pm * BM + wr * 64 + fr; const int col0 = u.pn * BM + wc * 32 + 4 * fq;
#pragma unroll
        for (int ai = 0; ai < 2; ++ai)
#pragma unroll
            for (int m = 0; m < 4; ++m) { const int row = row0 + ai * HALF + m * 16; const float r = rt[ai * HALF + m * 16];
#pragma unroll
                for (int bj = 0; bj < 2; ++bj)
#pragma unroll
                    for (int n = 0; n < 2; ++n) *(f32x4*)(C + (size_t)row * ldc + col0 + bj * HALF + n * 16) = acc[ai][bj][m][n] * r; }
    }
};

struct EpiMlaQ {
    static constexpr bool PERM = true, AFTER_DRAIN = false;
    bf16_t* Qm; const float* cosT; const float* sinT; const PG8_LAS float* rtab; float qscale0; mutable int ui;
    __device__ __forceinline__ void operator()(const f32x4 (&acc)[2][2][4][2], const Unit& u, int wr, int wc, int fr, int fq) const {
        const PG8_LAS float* rt = rtab + ui * 256 + wr * 64 + fr; ++ui;
        const int row0 = u.pm * BM + wr * 64 + fr;
        if (u.pn < 4) {
#pragma unroll
            for (int ai = 0; ai < 2; ++ai)
#pragma unroll
                for (int m = 0; m < 4; ++m) { const int row = row0 + ai * HALF + m * 16; const float qscale = qscale0 * rt[ai * HALF + m * 16];
#pragma unroll
                    for (int bj = 0; bj < 2; ++bj) *(u32x4*)(Qm + (size_t)row * 1536 + (2 * u.pn + bj) * 192 + wc * 32 + 8 * fq) = pack8(acc[ai][bj][m][0] * qscale, acc[ai][bj][m][1] * qscale); }
        } else {
            const int h = 4 * (u.pn - 4) + wc;
#pragma unroll
            for (int ai = 0; ai < 2; ++ai) {
                f32x4 cs[4][2][2];
#pragma unroll
                for (int m = 0; m < 4; ++m)
#pragma unroll
                    for (int n = 0; n < 2; ++n) { const size_t ro = (size_t)(row0 + ai * HALF + m * 16) * 32 + 8 * fq + 4 * n; cs[m][n][0] = *(const f32x4*)(cosT + ro); cs[m][n][1] = *(const f32x4*)(sinT + ro); }
#pragma unroll
                for (int m = 0; m < 4; ++m) { const int row = row0 + ai * HALF + m * 16; const float qscale = qscale0 * rt[ai * HALF + m * 16];
                    f32x4 o1[2], o2[2];
#pragma unroll
                    for (int n = 0; n < 2; ++n) { const f32x4 c = cs[m][n][0], s = cs[m][n][1];
                        const f32x4 x1 = acc[ai][0][m][n] * qscale, x2 = acc[ai][1][m][n] * qscale; o1[n] = x1 * c - x2 * s; o2[n] = x2 * c + x1 * s; }
                    bf16_t* p = Qm + (size_t)row * 1536 + h * 192 + 128 + 8 * fq;
                    *(u32x4*)p = pack8(o1[0], o1[1]); *(u32x4*)(p + 32) = pack8(o2[0], o2[1]); }
            }
        }
    }
};

struct EpiMlaKV {
    static constexpr bool PERM = true, AFTER_DRAIN = false;
    bf16_t *Km, *V; const PG8_LAS float* rtab; mutable int ui;
    __device__ __forceinline__ void operator()(const f32x4 (&acc)[2][2][4][2], const Unit& u, int wr, int wc, int fr, int fq) const {
        const PG8_LAS float* rt = rtab + ui * 256 + wr * 64 + fr; ++ui;
        const int row0 = u.pm * BM + wr * 64 + fr; const int h = u.pn, j0 = wc * 32 + 8 * fq;
#pragma unroll
        for (int ai = 0; ai < 2; ++ai)
#pragma unroll
            for (int m = 0; m < 4; ++m) { const int row = row0 + ai * HALF + m * 16; const float r = rt[ai * HALF + m * 16];
                *(u32x4*)(Km + (size_t)row * 1536 + h * 192 + j0) = pack8(acc[ai][0][m][0] * r, acc[ai][0][m][1] * r);
                *(u32x4*)(V + (size_t)row * 1024 + h * 128 + j0) = pack8(acc[ai][1][m][0] * r, acc[ai][1][m][1] * r); }
    }
};

struct EpiMlaIn {
    static constexpr bool PERM = true, AFTER_DRAIN = false;
    bf16_t *CQ, *CKV, *Km; float* S16; const PG8_LAS float* rtab; const float* cosT; const float* sinT; mutable int ui;
    __device__ __forceinline__ void operator()(const f32x4 (&acc)[2][2][4][2], const Unit& u, int wr, int wc, int fr, int fq) const {
        const PG8_LAS float* rt = rtab + ui * 256 + wr * 64 + fr; ++ui;
        const int row0 = u.pm * BM + wr * 64 + fr, i0 = 8 * fq;
#pragma unroll
        for (int ai = 0; ai < 2; ++ai)
#pragma unroll
            for (int m = 0; m < 4; ++m) { const int row = row0 + ai * HALF + m * 16; const float r = rt[ai * HALF + m * 16];
                float sq = 0.f, skv = 0.f;
                if (u.pn == 2 && wc == 3) {
                    f32x4 o1[2], o2[2];
#pragma unroll
                    for (int n = 0; n < 2; ++n) { const size_t ro = (size_t)row * 32 + i0 + 4 * n; const f32x4 c = *(const f32x4*)(cosT + ro), s = *(const f32x4*)(sinT + ro);
                        const f32x4 x1 = acc[ai][0][m][n] * r, x2 = acc[ai][1][m][n] * r; o1[n] = x1 * c - x2 * s; o2[n] = x2 * c + x1 * s; }
                    const u32x4 w1 = pack8(o1[0], o1[1]), w2 = pack8(o2[0], o2[1]);
#pragma unroll
                    for (int h = 0; h < 8; ++h) { bf16_t* p = Km + (size_t)row * 1536 + h * 192 + 128 + i0; *(u32x4*)p = w1; *(u32x4*)(p + 32) = w2; }
                } else {
                    const u32x4 w0 = pack8(acc[ai][0][m][0] * r, acc[ai][0][m][1] * r), w1 = pack8(acc[ai][1][m][0] * r, acc[ai][1][m][1] * r);
                    if (u.pn == 0) { *(u32x4*)(CQ + (size_t)row * 384 + wc * 32 + i0) = w0; *(u32x4*)(CQ + (size_t)row * 384 + 128 + wc * 32 + i0) = w1; sq = sumsq8(w0) + sumsq8(w1); }
                    else if (u.pn == 1) { *(u32x4*)(CQ + (size_t)row * 384 + 256 + wc * 32 + i0) = w0; sq = sumsq8(w0); *(u32x4*)(CKV + (size_t)row * 256 + wc * 32 + i0) = w1; skv = sumsq8(w1); }
                    else { *(u32x4*)(CKV + (size_t)row * 256 + 128 + wc * 32 + i0) = w0; skv = sumsq8(w0);
                           if (wc == 0) { *(u32x4*)(CKV + (size_t)row * 256 + 224 + i0) = w1; skv += sumsq8(w1); } }
                }
                sq += __shfl_xor(sq, 16); sq += __shfl_xor(sq, 32); skv += __shfl_xor(skv, 16); skv += __shfl_xor(skv, 32);
                if (fq == 0) { float* sl = S16 + (size_t)row * 16;
                    if (u.pn == 0) sl[wc] = sq; else if (u.pn == 1) { sl[4 + wc] = sq; sl[8 + wc] = skv; } else sl[12 + wc] = skv; }
            }
    }
};

__device__ __forceinline__ float rstd_half(const float* s16, int row, int first, float inv_n) { const f32x4* p = (const f32x4*)(s16 + (size_t)row * 16 + first); const f32x4 a = p[0], b = p[1];
    const float s = ((a[0] + a[1]) + (a[2] + a[3])) + ((b[0] + b[1]) + (b[2] + b[3])); return rsqrtf(s * inv_n + NORM_EPS); }
template <int MODE, class Sched> __device__ __forceinline__ void rstd_table_fill(PG8_LAS float* tab, const Sched& S, const float* ssq, int max_units) {
    int tid = threadIdx.x; asm volatile("" : "+v"(tid));
    const int half = tid >> 8, rr = tid & 255;
    for (int i0 = 0; i0 < max_units; i0 += 2) { Unit u; const int i = i0 + half; if (i < max_units && S.next(i, u)) { const int row = u.pm * BM + rr;
        tab[i * 256 + rr] = (MODE == 0) ? rstd1024(ssq, row) : (MODE == 1) ? rstd_half(ssq, row, 0, 1.0f / 384.0f) : rstd_half(ssq, row, 8, 1.0f / 256.0f); } }
    asm volatile("s_waitcnt lgkmcnt(0)" ::: "memory");
    __syncthreads();
}
template <class Epi, class Sched, bool ALIGN_EPI = false, bool SP2 = false>
__device__ __forceinline__ void gemm_phase(PG8_LAS unsigned char* lds, const Gemm g, const Sched& S, const Epi& E) {
    int tid = threadIdx.x; asm volatile("" : "+v"(tid));
    const int wid = __builtin_amdgcn_readfirstlane(tid >> 6), lane = tid & 63, wr = wid >> 2, wc = wid & 3, fr = lane & 15, fq = lane >> 4;
    int K = g.K; asm volatile("" : "+s"(K));
    const int nt = K / BK;
    unsigned voffA[2], voffB[2];
#pragma unroll
    for (int i = 0; i < 2; ++i) { int R, C; stage_rc(tid * 16 + i * 8192, R, C); const int Rb = Epi::PERM ? ((R & ~31) + perm32(R & 31)) : R;
        voffA[i] = (unsigned)(R * K + C) * 2u; voffB[i] = (unsigned)(Rb * K + C) * 2u; }
    const size_t kstep = (size_t)(BK * 2);
    const size_t hstep = (size_t)HALF * K * 2;
    const size_t tstep = 2 * hstep;
    const unsigned ldsw = (unsigned)wid * 1024u;
    const int aoff = lds_byte(wr * 64 + fr, fq * 8), boff = lds_byte(wc * 32 + fr, fq * 8);
#define PG8_SA(b, h) (((b) * 2 + (h)) * HTB)
#define PG8_SB(b, h) ((4 + (b) * 2 + (h)) * HTB)
#define PG8_STAGE(bufoff, gbase, voff) do { _Pragma("unroll") for (int _i = 0; _i < 2; ++_i) \
        __builtin_amdgcn_global_load_lds((const unsigned*)((const char*)(gbase) + (voff)[_i]), (PG8_LAS unsigned*)(lds + (bufoff) + ldsw + _i * 8192), 16, 0, 0); } while (0)
#define PG8_LDA(dst, b, h) do { _Pragma("unroll") for (int m = 0; m < 4; ++m) _Pragma("unroll") for (int k = 0; k < 2; ++k) dst[m][k] = *(const PG8_LAS bf16x8*)(lds + PG8_SA(b, h) + aoff + m * 2048 + k * 1024); } while (0)
#define PG8_LDB(dst, b, h) do { _Pragma("unroll") for (int n = 0; n < 2; ++n) _Pragma("unroll") for (int k = 0; k < 2; ++k) dst[n][k] = *(const PG8_LAS bf16x8*)(lds + PG8_SB(b, h) + boff + n * 2048 + k * 1024); } while (0)
#define PG8_MMA(ai, bj, At, Bt) do { __builtin_amdgcn_s_setprio(1); _Pragma("unroll") for (int m = 0; m < 4; ++m) _Pragma("unroll") for (int n = 0; n < 2; ++n) _Pragma("unroll") for (int k = 0; k < 2; ++k) \
        acc[ai][bj][m][n] = __builtin_amdgcn_mfma_f32_16x16x32_bf16(Bt[n][k], At[m][k], acc[ai][bj][m][n], 0, 0, 0); __builtin_amdgcn_s_setprio(0); } while (0)
#define PG8_WAIT_V(n) asm volatile("s_waitcnt vmcnt(" #n ")" ::: "memory")
#define PG8_WAIT_L(n) asm volatile("s_waitcnt lgkmcnt(" #n ")" ::: "memory")
#define PG8_BAR __builtin_amdgcn_s_barrier()
#define PG8_SCHED __builtin_amdgcn_sched_barrier(0)
    Unit cur, nxt; int ui = 0;
    if (!S.next(0, cur)) return;
    f32x4 acc[2][2][4][2];
#pragma unroll
    for (int a = 0; a < 2; ++a)
#pragma unroll
        for (int b = 0; b < 2; ++b)
#pragma unroll
            for (int m = 0; m < 4; ++m)
#pragma unroll
                for (int n = 0; n < 2; ++n) acc[a][b][m][n] = (f32x4){0.f, 0.f, 0.f, 0.f};
    bf16x8 At[4][2], B0[2][2], B1[2][2];
    const char* cA = (const char*)g.A + (size_t)cur.pm * tstep; const char* cB = (const char*)g.Bt + (size_t)cur.pn * tstep;
    S.a_ready(cur);
    if constexpr (SP2) {
        PG8_STAGE(PG8_SB(0, 0), cB, voffB); PG8_STAGE(PG8_SB(0, 1), cB + hstep, voffB); PG8_STAGE(PG8_SA(0, 0), cA, voffA); PG8_STAGE(PG8_SA(0, 1), cA + hstep, voffA);
        if (wr == 1) PG8_BAR;
        PG8_WAIT_V(2); PG8_BAR;
        PG8_STAGE(PG8_SB(1, 0), cB + kstep, voffB); PG8_STAGE(PG8_SA(1, 0), cA + kstep, voffA); PG8_STAGE(PG8_SB(1, 1), cB + hstep + kstep, voffB);
        PG8_WAIT_V(6); PG8_BAR;
    } else {
        PG8_STAGE(PG8_SB(0, 0), cB, voffB); PG8_STAGE(PG8_SA(0, 0), cA, voffA); PG8_STAGE(PG8_SB(0, 1), cB + hstep, voffB); PG8_STAGE(PG8_SA(0, 1), cA + hstep, voffA);
        if (wr == 1) PG8_BAR;
        PG8_WAIT_V(4); PG8_BAR;
        PG8_STAGE(PG8_SB(1, 0), cB + kstep, voffB); PG8_STAGE(PG8_SA(1, 0), cA + kstep, voffA); PG8_STAGE(PG8_SB(1, 1), cB + hstep + kstep, voffB);
        PG8_WAIT_V(6); PG8_BAR;
    }
    for (;;) {
        const bool has_next = S.next(ui + 1, nxt);
        const char* nA = has_next ? (const char*)g.A + (size_t)nxt.pm * tstep : cA; const char* nB = has_next ? (const char*)g.Bt + (size_t)nxt.pn * tstep : cB;
        for (int t = 0; t < nt; t += 2) {
            const bool last = (t == nt - 2);
            const char* a1 = cA + (size_t)(t + 1) * kstep;
            const char* a2 = last ? nA : cA + (size_t)(t + 2) * kstep; const char* b2 = last ? nB : cB + (size_t)(t + 2) * kstep;
            const char* a3 = a2 + kstep; const char* b3 = b2 + kstep;
            if (last && has_next) S.a_ready(nxt);
            if constexpr (SP2) {
            PG8_LDB(B0, 0, 0); PG8_LDB(B1, 0, 1); PG8_SCHED; PG8_LDA(At, 0, 0); PG8_STAGE(PG8_SA(1, 1), a1 + hstep, voffA);
            PG8_WAIT_V(8); PG8_WAIT_L(0); PG8_BAR; PG8_MMA(0, 0, At, B0); PG8_MMA(0, 1, At, B1); PG8_BAR; PG8_SCHED;
            PG8_LDA(At, 0, 1); PG8_STAGE(PG8_SB(0, 0), b2, voffB); PG8_STAGE(PG8_SB(0, 1), b2 + hstep, voffB); PG8_STAGE(PG8_SA(0, 0), a2, voffA);
            PG8_WAIT_V(8); PG8_WAIT_L(0); PG8_BAR; PG8_MMA(1, 0, At, B0); PG8_MMA(1, 1, At, B1); PG8_BAR; PG8_SCHED;
            PG8_LDB(B0, 1, 0); PG8_LDB(B1, 1, 1); PG8_SCHED; PG8_LDA(At, 1, 0); PG8_STAGE(PG8_SA(0, 1), a2 + hstep, voffA);
            PG8_WAIT_V(8); PG8_WAIT_L(0); PG8_BAR; PG8_MMA(0, 0, At, B0); PG8_MMA(0, 1, At, B1); PG8_BAR; PG8_SCHED;
            PG8_LDA(At, 1, 1); PG8_STAGE(PG8_SB(1, 0), b3, voffB); PG8_STAGE(PG8_SB(1, 1), b3 + hstep, voffB); PG8_STAGE(PG8_SA(1, 0), a3, voffA);
            PG8_WAIT_V(8); PG8_WAIT_L(0); PG8_BAR; PG8_MMA(1, 0, At, B0); PG8_MMA(1, 1, At, B1); PG8_BAR; PG8_SCHED;
            } else {
            PG8_LDB(B0, 0, 0); PG8_SCHED; PG8_LDA(At, 0, 0); PG8_STAGE(PG8_SA(1, 1), a1 + hstep, voffA);
            PG8_WAIT_L(8); PG8_BAR; PG8_WAIT_L(0); PG8_MMA(0, 0, At, B0); PG8_BAR; PG8_SCHED;
            PG8_LDB(B1, 0, 1); PG8_STAGE(PG8_SB(0, 0), b2, voffB);
            PG8_BAR; PG8_WAIT_L(0); PG8_MMA(0, 1, At, B1); PG8_BAR;
            PG8_LDA(At, 0, 1); PG8_STAGE(PG8_SA(0, 0), a2, voffA);
            PG8_BAR; PG8_WAIT_L(0); PG8_MMA(1, 0, At, B0); PG8_BAR; PG8_SCHED;
            PG8_STAGE(PG8_SB(0, 1), b2 + hstep, voffB);
            PG8_WAIT_V(6); PG8_BAR; PG8_MMA(1, 1, At, B1); PG8_BAR;
            PG8_LDB(B0, 1, 0); PG8_SCHED; PG8_LDA(At, 1, 0); PG8_STAGE(PG8_SA(0, 1), a2 + hstep, voffA);
            PG8_WAIT_L(8); PG8_BAR; PG8_WAIT_L(0); PG8_MMA(0, 0, At, B0); PG8_BAR; PG8_SCHED;
            PG8_LDB(B1, 1, 1); PG8_STAGE(PG8_SB(1, 0), b3, voffB);
            PG8_BAR; PG8_WAIT_L(0); PG8_MMA(0, 1, At, B1); PG8_BAR;
            PG8_LDA(At, 1, 1); PG8_STAGE(PG8_SA(1, 0), a3, voffA);
            PG8_BAR; PG8_WAIT_L(0); PG8_MMA(1, 0, At, B0); PG8_BAR; PG8_SCHED;
            PG8_STAGE(PG8_SB(1, 1), b3 + hstep, voffB);
            PG8_WAIT_V(6); PG8_BAR; PG8_MMA(1, 1, At, B1); PG8_BAR;
            }
        }
        if constexpr (ALIGN_EPI) { if (wr == 0) PG8_BAR; }
        if constexpr (!Epi::AFTER_DRAIN) { E(acc, cur, wr, wc, fr, fq); S.done(cur); }
        if (!has_next) break;
#pragma unroll
        for (int a = 0; a < 2; ++a)
#pragma unroll
            for (int b = 0; b < 2; ++b)
#pragma unroll
                for (int m = 0; m < 4; ++m)
#pragma unroll
                    for (int n = 0; n < 2; ++n) acc[a][b][m][n] = (f32x4){0.f, 0.f, 0.f, 0.f};
        cur = nxt; cA = nA; cB = nB; ++ui;
        if constexpr (ALIGN_EPI) { if (wr == 1) PG8_BAR; }
    }
    PG8_WAIT_V(0);
    if constexpr (!ALIGN_EPI) { if (wr == 0) PG8_BAR; }
    PG8_BAR;
    if constexpr (Epi::AFTER_DRAIN) { E.fused(acc, cur, wr, wc, fr, fq, lds, wid, lane); S.done(cur); }
#undef PG8_SA
#undef PG8_SB
#undef PG8_STAGE
#undef PG8_LDA
#undef PG8_LDB
#undef PG8_MMA
#undef PG8_WAIT_V
#undef PG8_WAIT_L
#undef PG8_BAR
#undef PG8_SCHED
}
}

constexpr int BATCH = 8, SEQ = 4096, DM = 1024, DFF = 2816, MTOK = BATCH * SEQ;
constexpr int NWAVES = 8;
#define LAS __attribute__((address_space(3)))
typedef unsigned short bf16;
typedef unsigned v4u __attribute__((ext_vector_type(4)));
typedef float f32x4 __attribute__((ext_vector_type(4)));
typedef float f32x2 __attribute__((ext_vector_type(2)));
__device__ __forceinline__ unsigned f2bf(float f) { unsigned u = __builtin_bit_cast(unsigned, f); return (u + 0x7fffu + ((u >> 16) & 1u)) >> 16; }
__device__ __forceinline__ unsigned pk2(float lo, float hi) { return f2bf(lo) | (f2bf(hi) << 16); }
__device__ __forceinline__ float wave_sum(float v) {
#pragma unroll
    for (int o = 1; o < 64; o <<= 1) v += __shfl_xor(v, o);
    return v;
}

namespace att {
typedef short bf16x8 __attribute__((ext_vector_type(8)));
typedef short s16x4 __attribute__((ext_vector_type(4)));
typedef short v4i16_t __attribute__((ext_vector_type(4)));
typedef float f32x16 __attribute__((ext_vector_type(16)));
typedef unsigned u32x4 __attribute__((ext_vector_type(4)));
constexpr int VP = 320;
template <int DQK> struct Geo { static constexpr int KP = (DQK + 8) * 2, KBUF = 64 * KP, VBUF = 64 * VP, VOFF = 2 * KBUF, WS_OFF = 2 * KBUF + 3 * VBUF, NKC = DQK / 64, CK = DQK / 8, LDS_NEED = WS_OFF + 8 * 256; };
__device__ __forceinline__ int crow(int r, int hi) { return (r & 3) + 8 * (r >> 2) + 4 * hi; }
__device__ __forceinline__ unsigned cvtpk(float lo, float hi) { typedef float f2 __attribute__((ext_vector_type(2))); typedef __bf16 b2 __attribute__((ext_vector_type(2))); f2 v = {lo, hi}; b2 b = __builtin_convertvector(v, b2); return __builtin_bit_cast(unsigned, b); }
__device__ __forceinline__ float xhalf_max(float m) { auto rr = __builtin_amdgcn_permlane32_swap(__float_as_uint(m), __float_as_uint(m), false, false); return fmaxf(__uint_as_float(rr[0]), __uint_as_float(rr[1])); }
__device__ __forceinline__ float xhalf_sum(float m) { auto rr = __builtin_amdgcn_permlane32_swap(__float_as_uint(m), __float_as_uint(m), false, false); return __uint_as_float(rr[0]) + __uint_as_float(rr[1]); }
__device__ __forceinline__ s16x4 vtr(const LAS unsigned char* p) { return __builtin_bit_cast(s16x4, __builtin_amdgcn_ds_read_tr16_b64_v4i16((LAS v4i16_t*)p)); }
#define ATT_MAX3(a, b, c) __builtin_fmaxf(__builtin_fmaxf((a), (b)), (c))

template <int DQK>
__device__ __forceinline__ void attn_pass(LAS unsigned char* lds, const bf16* Qp, int qpitch, const bf16* Kp, int kpitch, const bf16* Vp, int vpitch, int q0, f32x16 (&o)[4], float (&rl)[16]) {
    typedef Geo<DQK> G;
    constexpr float THR = 8.0f;
    constexpr bool NEGM = (DQK <= 64);
    int tid = threadIdx.x; asm volatile("" : "+v"(tid));
    const int lane = tid & 63, r32 = lane & 31, hi = lane >> 5;
    const int wid = __builtin_amdgcn_readfirstlane(tid >> 6);
    const bool shifted = (DQK <= 64) && wid >= 4;
    LAS float* wsf = (LAS float*)(lds + G::WS_OFF) + wid * 64;
    bf16x8 qf[DQK / 16];
    { const bf16* qrow = Qp + (size_t)(q0 + wid * 32 + r32) * qpitch + 8 * hi;
#pragma unroll
      for (int d0 = 0; d0 < DQK / 16; ++d0) qf[d0] = *(const bf16x8*)(qrow + 16 * d0); }
    const int NT = (q0 + 256) / 64;
    const int qw0 = q0 + wid * 32;
    constexpr bool PF2 = (DQK <= 64);
    u32x4 kreg[G::NKC], vreg[2], kreg2[G::NKC], vreg2[2];
    unsigned kgo[G::NKC], vgo[2];
#pragma unroll
    for (int i = 0; i < G::NKC; ++i) { const int id = tid + 512 * i, row = id / G::CK, ch = id % G::CK; kgo[i] = (unsigned)(row * kpitch + ch * 8) * 2u; }
#pragma unroll
    for (int i = 0; i < 2; ++i) { const int id = tid + 512 * i, row = id >> 4, ch = id & 15; vgo[i] = (unsigned)(row * vpitch + ch * 8) * 2u; }
#define ATT_LOADS(KR, VR, t) do { const char* kt_ = (const char*)(Kp + (size_t)(64 * (t)) * kpitch); const char* vt_ = (const char*)(Vp + (size_t)(64 * (t)) * vpitch); \
        _Pragma("unroll") for (int i = 0; i < G::NKC; ++i) KR[i] = *(const u32x4*)(kt_ + kgo[i]); \
        _Pragma("unroll") for (int i = 0; i < 2; ++i) VR[i] = *(const u32x4*)(vt_ + vgo[i]); } while (0)
#define ATT_STORES(KR, VR, kb_, vb_) do { \
        _Pragma("unroll") for (int i = 0; i < G::NKC; ++i) { const int id = tid + 512 * i, row = id / G::CK, ch = id % G::CK; *(LAS u32x4*)(lds + (kb_) * G::KBUF + row * G::KP + ch * 16) = KR[i]; } \
        _Pragma("unroll") for (int i = 0; i < 2; ++i) { const int id = tid + 512 * i, row = id >> 4, ch = id & 15; *(LAS u32x4*)(lds + G::VOFF + (vb_) * G::VBUF + row * VP + ch * 16) = VR[i]; } } while (0)
#define ATT_LOAD(t) ATT_LOADS(kreg, vreg, t)
#define ATT_STORE(kb_, vb_) ATT_STORES(kreg, vreg, kb_, vb_)
#define ATT_BAR() asm volatile("s_waitcnt lgkmcnt(0)\n\ts_barrier" ::: "memory")
#pragma unroll
    for (int db = 0; db < 4; ++db)
#pragma unroll
        for (int r = 0; r < 16; ++r) o[db][r] = 0.f;
    float mhat = 0.f, l = 0.f;
    f32x16 negm;
#pragma unroll
    for (int r = 0; r < 16; ++r) negm[r] = 0.f;
    u32x4 pw[4];
#define ATT_A(t) do { \
        f32x16 p0, p1; \
        const LAS unsigned char* kb = lds + ((t) & 1) * G::KBUF + r32 * G::KP + hi * 16; \
        __builtin_amdgcn_s_setprio(1); \
        _Pragma("unroll") for (int d0 = 0; d0 < DQK / 16; ++d0) { \
            const bf16x8 k0 = *(const LAS bf16x8*)(kb + 32 * d0), k1 = *(const LAS bf16x8*)(kb + 32 * G::KP + 32 * d0); \
            if (d0 == 0) { if (NEGM) { p0 = __builtin_amdgcn_mfma_f32_32x32x16_bf16(k0, qf[0], negm, 0, 0, 0); p1 = __builtin_amdgcn_mfma_f32_32x32x16_bf16(k1, qf[0], negm, 0, 0, 0); } \
                           else { f32x16 z; _Pragma("unroll") for (int r = 0; r < 16; ++r) z[r] = 0.f; p0 = __builtin_amdgcn_mfma_f32_32x32x16_bf16(k0, qf[0], z, 0, 0, 0); p1 = __builtin_amdgcn_mfma_f32_32x32x16_bf16(k1, qf[0], z, 0, 0, 0); } } \
            else { p0 = __builtin_amdgcn_mfma_f32_32x32x16_bf16(k0, qf[d0], p0, 0, 0, 0); p1 = __builtin_amdgcn_mfma_f32_32x32x16_bf16(k1, qf[d0], p1, 0, 0, 0); } } \
        __builtin_amdgcn_s_setprio(0); \
        if (!NEGM) { _Pragma("unroll") for (int r = 0; r < 16; ++r) { p0[r] -= mhat; p1[r] -= mhat; } } \
        if (64 * (t) + 63 > qw0) { const int qg = qw0 + r32, kb0 = 64 * (t) + 4 * hi; \
            _Pragma("unroll") for (int r = 0; r < 16; ++r) { const int kv = kb0 + (r & 3) + 8 * (r >> 2); if (kv > qg) p0[r] = -INFINITY; if (kv + 32 > qg) p1[r] = -INFINITY; } } \
        float ra = ATT_MAX3(p0[0], p0[1], p1[0]), rb = ATT_MAX3(p0[2], p0[3], p1[1]); ra = ATT_MAX3(ra, p1[2], p1[3]); \
        _Pragma("unroll") for (int r = 4; r < 16; r += 4) { ra = ATT_MAX3(ra, p0[r], p0[r + 1]); rb = ATT_MAX3(rb, p0[r + 2], p0[r + 3]); ra = ATT_MAX3(ra, p1[r], p1[r + 1]); rb = ATT_MAX3(rb, p1[r + 2], p1[r + 3]); } \
        const float rm = xhalf_max(fmaxf(ra, rb)); \
        if ((t) == 0 || __any(rm > THR)) { \
            const float dl = ((t) == 0) ? rm : fmaxf(rm, 0.f); mhat += dl; \
            _Pragma("unroll") for (int r = 0; r < 16; ++r) { p0[r] -= dl; p1[r] -= dl; if (NEGM) negm[r] = -mhat; } \
            if ((t) != 0) { const float f = __builtin_amdgcn_exp2f(-dl); l *= f; \
                if (hi == 0) wsf[r32] = f; \
                asm volatile("s_waitcnt lgkmcnt(0)" ::: "memory"); \
                float fr_[16]; \
                _Pragma("unroll") for (int r = 0; r < 16; ++r) fr_[r] = wsf[crow(r, hi)]; \
                _Pragma("unroll") for (int db = 0; db < 4; ++db) _Pragma("unroll") for (int r = 0; r < 16; ++r) o[db][r] *= fr_[r]; \
                asm volatile("s_waitcnt lgkmcnt(0)" ::: "memory"); } } \
        float s = 0.f; \
        _Pragma("unroll") for (int r = 0; r < 16; ++r) { p0[r] = __builtin_amdgcn_exp2f(p0[r]); p1[r] = __builtin_amdgcn_exp2f(p1[r]); s += p0[r] + p1[r]; } \
        l += s; \
        _Pragma("unroll") for (int w = 0; w < 4; ++w) { pw[0][w] = cvtpk(p0[2 * w], p0[2 * w + 1]); pw[1][w] = cvtpk(p0[8 + 2 * w], p0[9 + 2 * w]); pw[2][w] = cvtpk(p1[2 * w], p1[2 * w + 1]); pw[3][w] = cvtpk(p1[8 + 2 * w], p1[9 + 2 * w]); } \
    } while (0)
#define ATT_B(vbi) do { \
        const LAS unsigned char* vb = lds + G::VOFF + (vbi) * G::VBUF + (4 * hi + ((lane & 15) >> 2)) * VP + ((lane >> 4) & 1) * 32 + (lane & 3) * 8; \
        __builtin_amdgcn_s_setprio(1); \
        _Pragma("unroll") for (int c = 0; c < 4; ++c) { const bf16x8 pa = __builtin_bit_cast(bf16x8, pw[c]); \
            _Pragma("unroll") for (int db = 0; db < 4; ++db) { \
                const s16x4 lo = vtr(vb + c * 16 * VP + db * 64), hh = vtr(vb + c * 16 * VP + 8 * VP + db * 64); \
                const bf16x8 vf = {lo[0], lo[1], lo[2], lo[3], hh[0], hh[1], hh[2], hh[3]}; \
                o[db] = __builtin_amdgcn_mfma_f32_32x32x16_bf16(pa, vf, o[db], 0, 0, 0); } } \
        __builtin_amdgcn_s_setprio(0); \
    } while (0)
#define ATT_VIS(t) (64 * (t) <= qw0 + 31)
    ATT_LOAD(0); ATT_STORE(0, 0);
    if (PF2) ATT_LOADS(kreg2, vreg2, 1);
    ATT_BAR();
    int vcur = 0;
#define ATT_VNEXT(v) (((v) == 2) ? 0 : (v) + 1)
    if (PF2) {
        if (!shifted) {
            for (int t = 0; t < NT; t += 2) {
                const int v1 = ATT_VNEXT(vcur), v2 = ATT_VNEXT(v1);
                if (t + 2 < NT) ATT_LOADS(kreg, vreg, t + 2);
                if (ATT_VIS(t)) { ATT_A(t); ATT_B(vcur); }
                ATT_STORES(kreg2, vreg2, 1, v1);
                ATT_BAR();
                if (t + 3 < NT) ATT_LOADS(kreg2, vreg2, t + 3);
                if (ATT_VIS(t + 1)) { ATT_A(t + 1); ATT_B(v1); }
                if (t + 2 < NT) ATT_STORES(kreg, vreg, 0, v2);
                ATT_BAR();
                vcur = v2;
            }
        } else {
            int vprev = 2;
            for (int t = 0; t < NT; t += 2) {
                const int v1 = ATT_VNEXT(vcur), v2 = ATT_VNEXT(v1);
                if (t + 2 < NT) ATT_LOADS(kreg, vreg, t + 2);
                if (t > 0 && ATT_VIS(t - 1)) ATT_B(vprev);
                if (ATT_VIS(t)) ATT_A(t);
                ATT_STORES(kreg2, vreg2, 1, v1);
                ATT_BAR();
                if (t + 3 < NT) ATT_LOADS(kreg2, vreg2, t + 3);
                if (ATT_VIS(t)) ATT_B(vcur);
                if (ATT_VIS(t + 1)) ATT_A(t + 1);
                if (t + 2 < NT) ATT_STORES(kreg, vreg, 0, v2);
                ATT_BAR();
                vprev = v1; vcur = v2;
            }
            if (ATT_VIS(NT - 1)) ATT_B(vprev);
        }
    } else {
        for (int t = 0; t < NT; ++t) {
            const int vnext = ATT_VNEXT(vcur);
            if (t + 1 < NT) ATT_LOAD(t + 1);
            if (ATT_VIS(t)) { ATT_A(t); ATT_B(vcur); }
            if (t + 1 < NT) ATT_STORE((t + 1) & 1, vnext);
            vcur = vnext;
            ATT_BAR();
        }
    }
    ATT_BAR();
#undef ATT_LOAD
#undef ATT_STORE
#undef ATT_LOADS
#undef ATT_STORES
#undef ATT_BAR
#undef ATT_VNEXT
#undef ATT_A
#undef ATT_B
#undef ATT_VIS
    l = xhalf_sum(l);
    if (hi == 0) wsf[32 + r32] = l;
    asm volatile("s_waitcnt lgkmcnt(0)" ::: "memory");
#pragma unroll
    for (int r = 0; r < 16; ++r) rl[r] = 1.0f / wsf[32 + crow(r, hi)];
    asm volatile("s_waitcnt lgkmcnt(0)" ::: "memory");
}
__device__ __forceinline__ void glds16(const void* gsrc, unsigned lds_dst) { unsigned keep;
    asm volatile("s_mov_b32 %0, m0\n\ts_mov_b32 m0, %2\n\ts_nop 0\n\tglobal_load_lds_dwordx4 %1, off\n\ts_mov_b32 m0, %0" : "=&s"(keep) : "v"(gsrc), "s"(lds_dst) : "memory"); }
template <int DQK>
__device__ __forceinline__ void attn_pass4(LAS unsigned char* lds, const bf16* Qp, int qpitch, const bf16* Kp, int kpitch, const bf16* Vp, int vpitch, int q0, f32x16 (&o)[4], float (&rl)[16]) {
    typedef Geo<DQK> G;
    constexpr float THR = 8.0f;
    constexpr bool NEGM = true;
    int tid = threadIdx.x; asm volatile("" : "+v"(tid));
    const int lane = tid & 63, r32 = lane & 31, hi = lane >> 5;
    const int wid = __builtin_amdgcn_readfirstlane(tid >> 6);
    const bool shifted = wid >= 4;
    LAS float* wsf = (LAS float*)(lds + G::WS_OFF) + wid * 64;
    bf16x8 qf[DQK / 16];
    { const bf16* qrow = Qp + (size_t)(q0 + wid * 32 + r32) * qpitch + 8 * hi;
#pragma unroll
      for (int d0 = 0; d0 < DQK / 16; ++d0) qf[d0] = *(const bf16x8*)(qrow + 16 * d0); }
    const int NT = (q0 + 256) / 64;
    const int qw0 = q0 + wid * 32;
    const unsigned lds0 = (unsigned)(size_t)lds;
    constexpr int KS = G::KP / 16, KD = DQK / 8, KJ = (KS + 7) / 8, VS = VP / 16, VD = 16, VJ = (VS + 7) / 8;
    unsigned koff[KJ], voff[VJ];
#pragma unroll
    for (int j = 0; j < KJ; ++j) { const int sidx = (j * 8 + wid) * 64 + lane, row = (sidx / KS) & 63, c = sidx % KS; koff[j] = (unsigned)(row * kpitch + (c < KD ? c : KD - 1) * 8) * 2u; }
#pragma unroll
    for (int j = 0; j < VJ; ++j) { const int sidx = (j * 8 + wid) * 64 + lane, row = (sidx / VS) & 63, c = sidx % VS; voff[j] = (unsigned)(row * vpitch + (c < VD ? c : VD - 1) * 8) * 2u; }
#define ATT_DMA(t, kb_, vb_) do { const char* kt_ = (const char*)(Kp + (size_t)(64 * (t)) * kpitch); const char* vt_ = (const char*)(Vp + (size_t)(64 * (t)) * vpitch); \
        _Pragma("unroll") for (int j = 0; j < KJ; ++j) { const int q = j * 8 + wid; if (q < KS) glds16(kt_ + koff[j], (unsigned)__builtin_amdgcn_readfirstlane((int)(lds0 + (unsigned)((kb_) * G::KBUF + q * 1024)))); } \
        _Pragma("unroll") for (int j = 0; j < VJ; ++j) { const int q = j * 8 + wid; if (q < VS) glds16(vt_ + voff[j], (unsigned)__builtin_amdgcn_readfirstlane((int)(lds0 + (unsigned)(G::VOFF + (vb_) * G::VBUF + q * 1024)))); } } while (0)
#define ATT_BAR() asm volatile("s_waitcnt vmcnt(0) lgkmcnt(0)\n\ts_barrier" ::: "memory")
#pragma unroll
    for (int db = 0; db < 4; ++db)
#pragma unroll
        for (int r = 0; r < 16; ++r) o[db][r] = 0.f;
    float mhat = 0.f, l = 0.f;
    f32x16 negm;
#pragma unroll
    for (int r = 0; r < 16; ++r) negm[r] = 0.f;
    u32x4 pw[4];
#define ATT_A(t) do { \
        f32x16 p0, p1; \
        const LAS unsigned char* kb = lds + ((t) & 1) * G::KBUF + r32 * G::KP + hi * 16; \
        __builtin_amdgcn_s_setprio(1); \
        _Pragma("unroll") for (int d0 = 0; d0 < DQK / 16; ++d0) { \
            const bf16x8 k0 = *(const LAS bf16x8*)(kb + 32 * d0), k1 = *(const LAS bf16x8*)(kb + 32 * G::KP + 32 * d0); \
            if (d0 == 0) { if (NEGM) { p0 = __builtin_amdgcn_mfma_f32_32x32x16_bf16(k0, qf[0], negm, 0, 0, 0); p1 = __builtin_amdgcn_mfma_f32_32x32x16_bf16(k1, qf[0], negm, 0, 0, 0); } \
                           else { f32x16 z; _Pragma("unroll") for (int r = 0; r < 16; ++r) z[r] = 0.f; p0 = __builtin_amdgcn_mfma_f32_32x32x16_bf16(k0, qf[0], z, 0, 0, 0); p1 = __builtin_amdgcn_mfma_f32_32x32x16_bf16(k1, qf[0], z, 0, 0, 0); } } \
            else { p0 = __builtin_amdgcn_mfma_f32_32x32x16_bf16(k0, qf[d0], p0, 0, 0, 0); p1 = __builtin_amdgcn_mfma_f32_32x32x16_bf16(k1, qf[d0], p1, 0, 0, 0); } } \
        __builtin_amdgcn_s_setprio(0); \
        if (!NEGM) { _Pragma("unroll") for (int r = 0; r < 16; ++r) { p0[r] -= mhat; p1[r] -= mhat; } } \
        if (64 * (t) + 63 > qw0) { const int qg = qw0 + r32, kb0 = 64 * (t) + 4 * hi; \
            _Pragma("unroll") for (int r = 0; r < 16; ++r) { const int kv = kb0 + (r & 3) + 8 * (r >> 2); if (kv > qg) p0[r] = -INFINITY; if (kv + 32 > qg) p1[r] = -INFINITY; } } \
        float ra = ATT_MAX3(p0[0], p0[1], p1[0]), rb = ATT_MAX3(p0[2], p0[3], p1[1]); ra = ATT_MAX3(ra, p1[2], p1[3]); \
        _Pragma("unroll") for (int r = 4; r < 16; r += 4) { ra = ATT_MAX3(ra, p0[r], p0[r + 1]); rb = ATT_MAX3(rb, p0[r + 2], p0[r + 3]); ra = ATT_MAX3(ra, p1[r], p1[r + 1]); rb = ATT_MAX3(rb, p1[r + 2], p1[r + 3]); } \
        const float rm = xhalf_max(fmaxf(ra, rb)); \
        if ((t) == 0 || __any(rm > THR)) { \
            const float dl = ((t) == 0) ? rm : fmaxf(rm, 0.f); mhat += dl; \
            _Pragma("unroll") for (int r = 0; r < 16; ++r) { p0[r] -= dl; p1[r] -= dl; if (NEGM) negm[r] = -mhat; } \
            if ((t) != 0) { const float f = __builtin_amdgcn_exp2f(-dl); l *= f; \
                if (hi == 0) wsf[r32] = f; \
                asm volatile("s_waitcnt lgkmcnt(0)" ::: "memory"); \
                float fr_[16]; \
                _Pragma("unroll") for (int r = 0; r < 16; ++r) fr_[r] = wsf[crow(r, hi)]; \
                _Pragma("unroll") for (int db = 0; db < 4; ++db) _Pragma("unroll") for (int r = 0; r < 16; ++r) o[db][r] *= fr_[r]; \
                asm volatile("s_waitcnt lgkmcnt(0)" ::: "memory"); } } \
        float s = 0.f; \
        _Pragma("unroll") for (int r = 0; r < 16; ++r) { p0[r] = __builtin_amdgcn_exp2f(p0[r]); p1[r] = __builtin_amdgcn_exp2f(p1[r]); s += p0[r] + p1[r]; } \
        l += s; \
        _Pragma("unroll") for (int w = 0; w < 4; ++w) { pw[0][w] = cvtpk(p0[2 * w], p0[2 * w + 1]); pw[1][w] = cvtpk(p0[8 + 2 * w], p0[9 + 2 * w]); pw[2][w] = cvtpk(p1[2 * w], p1[2 * w + 1]); pw[3][w] = cvtpk(p1[8 + 2 * w], p1[9 + 2 * w]); } \
    } while (0)
#define ATT_B(vbi) do { \
        const LAS unsigned char* vb = lds + G::VOFF + (vbi) * G::VBUF + (4 * hi + ((lane & 15) >> 2)) * VP + ((lane >> 4) & 1) * 32 + (lane & 3) * 8; \
        __builtin_amdgcn_s_setprio(1); \
        _Pragma("unroll") for (int c = 0; c < 4; ++c) { const bf16x8 pa = __builtin_bit_cast(bf16x8, pw[c]); \
            _Pragma("unroll") for (int db = 0; db < 4; ++db) { \
                const s16x4 lo = vtr(vb + c * 16 * VP + db * 64), hh = vtr(vb + c * 16 * VP + 8 * VP + db * 64); \
                const bf16x8 vf = {lo[0], lo[1], lo[2], lo[3], hh[0], hh[1], hh[2], hh[3]}; \
                o[db] = __builtin_amdgcn_mfma_f32_32x32x16_bf16(pa, vf, o[db], 0, 0, 0); } } \
        __builtin_amdgcn_s_setprio(0); \
    } while (0)
#define ATT_VIS(t) (64 * (t) <= qw0 + 31)
    ATT_DMA(0, 0, 0); ATT_BAR();
    int vcur = 0;
#define ATT_VNEXT(v) (((v) == 2) ? 0 : (v) + 1)
    if (!shifted) {
        for (int t = 0; t < NT; ++t) {
            const int vnext = ATT_VNEXT(vcur);
            if (t + 1 < NT) ATT_DMA(t + 1, (t + 1) & 1, vnext);
            if (ATT_VIS(t)) { ATT_A(t); ATT_B(vcur); }
            vcur = vnext;
            ATT_BAR();
        }
    } else {
        int vprev = 2;
        for (int t = 0; t < NT; ++t) {
            const int vnext = ATT_VNEXT(vcur);
            if (t + 1 < NT) ATT_DMA(t + 1, (t + 1) & 1, vnext);
            if (t > 0 && ATT_VIS(t - 1)) ATT_B(vprev);
            if (ATT_VIS(t)) ATT_A(t);
            vprev = vcur; vcur = vnext;
            ATT_BAR();
        }
        if (ATT_VIS(NT - 1)) ATT_B(vprev);
    }
    ATT_BAR();
#undef ATT_DMA
#undef ATT_BAR
#undef ATT_VNEXT
#undef ATT_A
#undef ATT_B
#undef ATT_VIS
    l = xhalf_sum(l);
    if (hi == 0) wsf[32 + r32] = l;
    asm volatile("s_waitcnt lgkmcnt(0)" ::: "memory");
#pragma unroll
    for (int r = 0; r < 16; ++r) rl[r] = 1.0f / wsf[32 + crow(r, hi)];
    asm volatile("s_waitcnt lgkmcnt(0)" ::: "memory");
}
}

constexpr size_t MiB = 1u << 20;
constexpr size_t WS_SSQ = 9 * MiB;
constexpr size_t WS_COS = 1 * MiB, WS_SIN = 5 * MiB;
constexpr size_t WS_O0 = 185 * MiB + 256 * MiB;
constexpr size_t WS_W = 41 * MiB;
constexpr size_t W_GU = (size_t)2 * DFF * DM * 2, W_DN = (size_t)DM * DFF * 2, W_FFN = W_GU + W_DN;
constexpr size_t WS_WFFN = WS_W;
constexpr size_t WS_WDIN = WS_WFFN + 4 * W_FFN, WS_WDOUT = WS_WDIN + (size_t)3072 * 1024 * 2, WS_WMIN = WS_WDOUT + (size_t)1024 * 1024 * 2, WS_WMQ = WS_WMIN + (size_t)768 * 1024 * 2,
                 WS_WMKV = WS_WMQ + (size_t)1536 * 384 * 2, WS_WMOUT = WS_WMKV + (size_t)2048 * 256 * 2, WS_WEND = WS_WMOUT + (size_t)1024 * 1024 * 2;
constexpr size_t WS_XB = 121 * MiB;
constexpr size_t WS_R = 185 * MiB;
constexpr size_t WS_ACT = WS_R;
constexpr size_t WS_DQ = WS_R, WS_DK = WS_R + 64 * MiB, WS_DV = WS_R + 128 * MiB, WS_DAO = WS_R + 192 * MiB;
constexpr size_t WS_MQ = WS_R, WS_MC = WS_R, WS_MK = WS_R + 96 * MiB, WS_MV = WS_R + 192 * MiB, WS_MAO = WS_R + 256 * MiB;
constexpr size_t WS_MCQ = WS_MAO, WS_MCKV = WS_MAO + 24 * MiB;
constexpr size_t WS_END = WS_R + 320 * MiB;
static_assert(WS_WEND <= WS_XB && WS_ACT + (size_t)MTOK * DFF * 2 <= WS_END && WS_END <= 512 * MiB, "workspace map");

#ifndef ATT_REPS
#define ATT_REPS 1
#endif
#ifndef DIFF_REPS
#define DIFF_REPS 1
#endif
constexpr int LDS_BYTES = 147456, XB_LDS_OFF = 131072 + 1024, RTAB_OFF = 131072 + 2048, RTAB_UNITS = 12;
static_assert(RTAB_OFF + RTAB_UNITS * 1024 <= LDS_BYTES, "LDS map");
constexpr size_t WS_PCNT = 16384;
constexpr size_t WS_BAR = 0;

struct WDesc { const float* W; const float* gain; bf16* WT; int K, N, mode, item0; };
constexpr int NWD = 22;
struct Args {
    const float* x; const int* pos;
    const float *lq1, *lk1, *lq2, *lk2, *sub_gain, *mq_norm, *mkv_norm, *final_norm;
    float* out; unsigned char* ws;
    WDesc wd[NWD];
    int nitems, nearly;
};

#define XB_TMO      128
#define XB_XCNT(j)  (256  + 64 * (j))
#define XB_XSUB(j)  (1280 + 64 * (j))
#define XB_XGEN(j)  (2304 + 64 * (j))
#define XB_TOP      3328
#define XB_TOPGEN   3392
#define XCD_BAR_WORDS 3456
#define XB_SPIN_CAP (1u << 18)

__device__ __forceinline__ unsigned xb_ld(unsigned* p)              { return __hip_atomic_load(p, __ATOMIC_RELAXED, __HIP_MEMORY_SCOPE_AGENT); }
__device__ __forceinline__ unsigned xb_add(unsigned* p, unsigned v) { return __hip_atomic_fetch_add(p, v, __ATOMIC_RELAXED, __HIP_MEMORY_SCOPE_AGENT); }
__device__ __forceinline__ unsigned xb_xcc_id() { return (unsigned)__builtin_amdgcn_s_getreg((3 << 11) | 20) & 0xFu; }
#define XB_SPIN(cond, bar) do { unsigned _sp = 0; while (cond) { __builtin_amdgcn_s_sleep(1); \
    if ((++_sp & 255u) == 0u) { if (xb_ld(&(bar)[XB_TMO])) break; if (_sp > XB_SPIN_CAP) { atomicAdd(&(bar)[XB_TMO], 1u); break; } } } } while (0)

struct XcdBarrier {
    unsigned* bar; unsigned x;
    volatile LAS unsigned* st;
};

__device__ __forceinline__ XcdBarrier xcd_barrier_post(unsigned* bar, volatile LAS unsigned* st) {
    XcdBarrier b; b.bar = bar; b.x = xb_xcc_id(); b.st = st;
    if (threadIdx.x == 0) (void)xb_add(&bar[XB_XCNT(b.x)], 1u);
    return b;
}
__device__ __forceinline__ void xcd_barrier_complete(unsigned* bar, unsigned x, unsigned& nloc, unsigned& nx) {
    const unsigned G = gridDim.x * gridDim.y * gridDim.z;
    unsigned sum, cnt, mine, sp = 0u;
    for (;;) {
        sum = 0u; cnt = 0u; mine = 0u;
#pragma unroll
        for (unsigned j = 0; j < 16; ++j) { const unsigned c = xb_ld(&bar[XB_XCNT(j)]); sum += c; cnt += (c > 0u) ? 1u : 0u; mine = (j == x) ? c : mine; }
        if (sum == G) break;
        __builtin_amdgcn_s_sleep(1);
        if ((++sp & 255u) == 0u) { if (xb_ld(&bar[XB_TMO])) break; if (sp > XB_SPIN_CAP) { atomicAdd(&bar[XB_TMO], 1u); break; } }
    }
    nloc = mine > 0u ? mine : 1u; nx = cnt > 0u ? cnt : 1u;
}

__device__ __forceinline__ void xcd_barrier(const XcdBarrier& b) {
    asm volatile("s_waitcnt vmcnt(0)" ::: "memory");
    __syncthreads();
    if (threadIdx.x == 0) {
        unsigned* bar = b.bar;
        __builtin_amdgcn_s_waitcnt(0);
        unsigned nloc = b.st[0], nx = b.st[1];
        if (nloc == 0u) { xcd_barrier_complete(bar, b.x, nloc, nx); b.st[0] = nloc; b.st[1] = nx; }
        const unsigned old = xb_add(&bar[XB_XSUB(b.x)], 1u);
        const unsigned gen = old / nloc;
        if (old + 1u == (gen + 1u) * nloc) {
            __builtin_amdgcn_fence(__ATOMIC_RELEASE, "agent");
            asm volatile("s_waitcnt vmcnt(0)" ::: "memory");
            const unsigned og = xb_add(&bar[XB_TOP], 1u);
            const unsigned tg = og / nx;
            if (og + 1u == (tg + 1u) * nx) xb_add(&bar[XB_TOPGEN], 1u);
            else XB_SPIN(xb_ld(&bar[XB_TOPGEN]) == tg, bar);
            __builtin_amdgcn_fence(__ATOMIC_ACQUIRE, "agent");
            xb_add(&bar[XB_XGEN(b.x)], 1u);
            asm volatile("s_waitcnt vmcnt(0)" ::: "memory");
        } else {
            XB_SPIN(xb_ld(&bar[XB_XGEN(b.x)]) == gen, bar);
            __builtin_amdgcn_fence(__ATOMIC_ACQUIRE, "agent");
            asm volatile("s_waitcnt vmcnt(0)" ::: "memory");
        }
    }
    __syncthreads();
}

__device__ __forceinline__ int wmap(int mode, int n) {
    switch (mode) {
        case 1: return 256 * (n >> 7) + (n & 127);
        case 2: return 256 * (n >> 7) + 128 + (n & 127);
        case 3: { if (n >= 2048) return n; const int chunk = n >> 6, half = (n >> 5) & 1, i = n & 31; return 256 * (chunk >> 2) + 128 * half + 32 * (chunk & 3) + i; }
        case 4: { const int h = n / 192, j = n - 192 * h; if (j < 128) return h * 128 + j; const int i = j - 128, half = i >> 5, ii = i & 31; return 1024 + 256 * (h >> 2) + 128 * half + 32 * (h & 3) + ii; }
        case 5: { if (n < 608) return n; if (n < 640) return n + 32; if (n < 672) return n - 32; return n + 64; }
        default: return n;
    }
}
__device__ __forceinline__ void tr_load(float (&wv)[32], const float* W, int N, int nblk, int item, int lane) {
    const int kb = item / nblk, nb = item - kb * nblk, k0 = 64 * kb, n0 = 32 * nb;
#pragma unroll
    for (int i = 0; i < 32; ++i) wv[i] = __builtin_nontemporal_load(&W[(size_t)(k0 + 2 * i + (lane >> 5)) * N + n0 + (lane & 31)]);
}
__device__ __forceinline__ void tr_store(const float (&wv)[32], const float* gain, int K, int nblk, bf16* WT, int mode, LAS float* scr, int item, int lane) {
    const int kb = item / nblk, nb = item - kb * nblk, k0 = 64 * kb, n0 = 32 * nb;
    f32x4 g0 = {1.f, 1.f, 1.f, 1.f}, g1 = g0;
    if (gain) { g0 = *(const f32x4*)(gain + k0 + 8 * (lane & 7)); g1 = *(const f32x4*)(gain + k0 + 8 * (lane & 7) + 4); }
#pragma unroll
    for (int i = 0; i < 32; ++i) scr[(2 * i + (lane >> 5)) * 33 + (lane & 31)] = wv[i];
    asm volatile("s_waitcnt lgkmcnt(0)" ::: "memory");
    const int c = lane & 7;
#pragma unroll
    for (int j = 0; j < 4; ++j) { const int n = (lane >> 3) + 8 * j; const LAS float* sp = scr + (8 * c) * 33 + n;
        v4u o; o.x = pk2(sp[0 * 33] * g0[0], sp[1 * 33] * g0[1]); o.y = pk2(sp[2 * 33] * g0[2], sp[3 * 33] * g0[3]); o.z = pk2(sp[4 * 33] * g1[0], sp[5 * 33] * g1[1]); o.w = pk2(sp[6 * 33] * g1[2], sp[7 * 33] * g1[3]);
        *(v4u*)(WT + (size_t)wmap(mode, n0 + n) * K + k0 + 8 * c) = o; }
    asm volatile("s_waitcnt lgkmcnt(0)" ::: "memory");
}

__global__ void __launch_bounds__(NWAVES * 64, 2) fwd_kernel(Args args) {
    extern __shared__ __attribute__((aligned(16))) unsigned char lds_raw[];
    LAS unsigned char* lds = (LAS unsigned char*)lds_raw;
    cg::grid_group cgrid = cg::this_grid();
    if (threadIdx.x < 2) ((volatile LAS unsigned*)(lds + XB_LDS_OFF))[threadIdx.x] = 0u;
    __syncthreads();
    XcdBarrier xbar;
    struct GridSeam { XcdBarrier* b; __device__ __forceinline__ void sync() const { xcd_barrier(*b); } } grid{&xbar};
    const int G = gridDim.x, bx = blockIdx.x;
    const int vcu = (G % 8 == 0) ? (bx % 8) * (G / 8) + bx / 8 : bx;
    const int NGW = G * NWAVES;
#define PHASE_IDS() int tid = threadIdx.x; asm volatile("" : "+v"(tid)); const int lane = tid & 63, wave = __builtin_amdgcn_readfirstlane(tid >> 6); const int gw = vcu * NWAVES + wave; (void)lane; (void)gw
    unsigned char* ws = args.ws;
    float* ssq = (float*)(ws + WS_SSQ);
    float* cosT = (float*)(ws + WS_COS); float* sinT = (float*)(ws + WS_SIN);
    bf16* XB = (bf16*)(ws + WS_XB);
    float* X = args.out;

    {
        PHASE_IDS();
        LAS float* scr = (LAS float*)(lds + wave * 16384);
#define PRO_FIND(g, mi_) do { mi_ = 0; for (int j_ = 1; j_ < NWD; ++j_) if ((g) >= args.wd[j_].item0) mi_ = j_; } while (0)
#define PRO_LOAD(wv_, g) do { int mi_; PRO_FIND(g, mi_); const int N_ = args.wd[mi_].N; tr_load(wv_, args.wd[mi_].W, N_, N_ / 32, (g) - args.wd[mi_].item0, lane); } while (0)
#define PRO_STORE(wv_, g) do { int mi_; PRO_FIND(g, mi_); tr_store(wv_, args.wd[mi_].gain, args.wd[mi_].K, args.wd[mi_].N / 32, args.wd[mi_].WT, args.wd[mi_].mode, scr, (g) - args.wd[mi_].item0, lane); } while (0)
        {
            const int total = args.nearly; float wa[32], wb[32];
            int g = gw;
            if (g < total) {
                PRO_LOAD(wa, g);
                for (;;) {
                    const bool n1 = g + NGW < total;
                    if (n1) PRO_LOAD(wb, g + NGW);
                    PRO_STORE(wa, g);
                    if (!n1) break;
                    g += NGW;
                    const bool n2 = g + NGW < total;
                    if (n2) PRO_LOAD(wa, g + NGW);
                    PRO_STORE(wb, g);
                    if (!n2) break;
                    g += NGW;
                }
            }
        }
        { v4u* z = (v4u*)(ws + WS_WMIN + (size_t)672 * 1024 * 2); const int nz = 64 * 1024 * 2 / 16; for (int i = bx * 512 + tid; i < nz; i += G * 512) z[i] = (v4u){0u, 0u, 0u, 0u}; }
        for (int i = bx * 512 + tid; i < MTOK * 32; i += G * 512) { const int row = i >> 5, fi = i & 31; const float inv = exp2f(-(float)fi * (13.287712379549449f / 32.0f)); const float ang = (float)args.pos[row] * inv; float sv, cv; sincosf(ang, &sv, &cv); cosT[i] = cv; sinT[i] = sv; }
        if (bx == 0) for (int i = tid; i < XCD_BAR_WORDS; i += 512) ((unsigned*)(ws + WS_BAR))[i] = 0u;
        if (bx == 1 % G) for (int i = tid; i < 128 * 64; i += 512) ((unsigned*)(ws + WS_PCNT))[i] = 0u;
        for (int mrow0 = gw; mrow0 < MTOK; mrow0 += 2 * NGW) {
            const bool two = mrow0 + NGW < MTOK; const int mrow1 = two ? mrow0 + NGW : mrow0;
            f32x4 va[4], vb[4];
#pragma unroll
            for (int j = 0; j < 4; ++j) { va[j] = __builtin_nontemporal_load(((const f32x4*)(args.x + (size_t)mrow0 * DM) + lane) + 64 * j); vb[j] = __builtin_nontemporal_load(((const f32x4*)(args.x + (size_t)mrow1 * DM) + lane) + 64 * j); }
#pragma unroll
            for (int rr = 0; rr < 2; ++rr) { if (rr == 1 && !two) break; const int mrow = rr ? mrow1 : mrow0; float s = 0.f; unsigned long long* o8 = (unsigned long long*)(XB + (size_t)mrow * DM) + lane;
#pragma unroll
                for (int j = 0; j < 4; ++j) { const f32x4 v = rr ? vb[j] : va[j]; const unsigned w0 = pk2(v.x, v.y), w1 = pk2(v.z, v.w); o8[64 * j] = (unsigned long long)w0 | ((unsigned long long)w1 << 32);
                    const float r0 = __uint_as_float(w0 << 16), r1 = __uint_as_float(w0 & 0xffff0000u), r2 = __uint_as_float(w1 << 16), r3 = __uint_as_float(w1 & 0xffff0000u); s += (r0 * r0 + r1 * r1) + (r2 * r2 + r3 * r3); }
                s = wave_sum(s); if (lane < 16) ssq[(size_t)mrow * 16 + lane] = (lane == 0) ? s : 0.f; }
        }
    }
    cgrid.sync();
    xbar = xcd_barrier_post((unsigned*)(ws + WS_BAR), (volatile LAS unsigned*)(lds + XB_LDS_OFF));

    const float C2_DIFF = 0.125f * 1.4426950408889634f;
    const float C2_MLA = 0.07216878364870322f * 1.4426950408889634f;

#define FFN_PHASES(widx, ssq_in, ssq_out) do { \
        { pg8::Gemm g{XB, (const bf16*)(ws + WS_WFFN + (size_t)(widx) * W_FFN), MTOK, 2 * DFF, DM}; pg8::StaticOrder S; S.init(MTOK, 2 * DFF, G, bx); \
          pg8::rstd_table_fill<0>((LAS float*)(lds + RTAB_OFF), S, ssq + (size_t)(ssq_in) * MTOK * 16, RTAB_UNITS); \
          pg8::EpiSwiglu E{(bf16*)(ws + WS_ACT), DFF, (const LAS float*)(lds + RTAB_OFF), 0}; \
          pg8::gemm_phase<pg8::EpiSwiglu, pg8::StaticOrder, true, true>(lds, g, S, E); } \
        grid.sync(); \
        { pg8::Gemm g{(const bf16*)(ws + WS_ACT), (const bf16*)(ws + WS_WFFN + (size_t)(widx) * W_FFN + W_GU), MTOK, DM, DFF}; pg8::StaticOrder S; S.init(MTOK, DM, G, bx); \
          pg8::EpiResid E{XB, ssq + (size_t)(ssq_out) * MTOK * 16, 0.5f}; \
          pg8::gemm_phase<pg8::EpiResid, pg8::StaticOrder, true, true>(lds, g, S, E); } \
        grid.sync(); } while (0)

    FFN_PHASES(0, 0, 1);
    { pg8::Gemm g{XB, (const bf16*)(ws + WS_WDIN), MTOK, 3072, DM}; pg8::StaticOrder S; S.init(MTOK, 3072, G, bx);
      pg8::rstd_table_fill<0>((LAS float*)(lds + RTAB_OFF), S, ssq + (size_t)1 * MTOK * 16, RTAB_UNITS);
      pg8::EpiDiffQKV E{(bf16*)(ws + WS_DQ), (bf16*)(ws + WS_DK), (bf16*)(ws + WS_DV), (const LAS float*)(lds + RTAB_OFF), cosT, sinT, C2_DIFF, 0};
      pg8::gemm_phase<pg8::EpiDiffQKV, pg8::StaticOrder, true, true>(lds, g, S, E); }
    grid.sync();
    {
        PHASE_IDS();
        float lam;
        { float a = 0.f, b = 0.f; for (int i = 0; i < 64; ++i) { a += args.lq1[i] * args.lk1[i]; b += args.lq2[i] * args.lk2[i]; } lam = expf(a) - expf(b) + 0.2f; }
        const float post = 1.0f - 0.2f;
        const bf16* Qd = (const bf16*)(ws + WS_DQ); const bf16* Kd = (const bf16*)(ws + WS_DK); const bf16* Vd = (const bf16*)(ws + WS_DV); bf16* AO = (bf16*)(ws + WS_DAO);
        LAS float* scr = (LAS float*)(lds + wave * 16384);
        float wvl[32]; int late_g = args.nearly + gw; bool late_have = late_g < args.nitems;
        if (late_have) PRO_LOAD(wvl, late_g);
#define LATE_STEP() do { if (late_have) { PRO_STORE(wvl, late_g); late_g += NGW; late_have = late_g < args.nitems; if (late_have) PRO_LOAD(wvl, late_g); } __syncthreads(); } while (0)
        for (int rep = 0; rep < DIFF_REPS; ++rep)
        for (int pi = vcu; pi < 512; pi += G) {
            const int bh = pi >> 3, s8 = pi & 7, b = bh >> 3, h = bh & 7;
            for (int half = 0; half < 2; ++half) {
                const int qb = half ? s8 : 15 - s8;
                att::f32x16 o[4]; float rl[16];
                const size_t rb = (size_t)b * SEQ * 1024;
                att::attn_pass4<64>(lds, Qd + rb + (2 * h) * 64, 1024, Kd + rb + (2 * h) * 64, 1024, Vd + rb + h * 128, 1024, qb * 256, o, rl);
                LATE_STEP();
                int t1 = threadIdx.x; asm volatile("" : "+v"(t1));
                f32x4* scrO = (f32x4*)((float*)(ws + WS_O0) + ((size_t)bx * 512 + t1) * 64);
#pragma unroll
                for (int db = 0; db < 4; ++db)
#pragma unroll
                    for (int r4 = 0; r4 < 4; ++r4) scrO[db * 4 + r4] = (f32x4){o[db][4 * r4] * rl[4 * r4], o[db][4 * r4 + 1] * rl[4 * r4 + 1], o[db][4 * r4 + 2] * rl[4 * r4 + 2], o[db][4 * r4 + 3] * rl[4 * r4 + 3]};
                att::attn_pass4<64>(lds, Qd + rb + (2 * h + 1) * 64, 1024, Kd + rb + (2 * h + 1) * 64, 1024, Vd + rb + h * 128, 1024, qb * 256, o, rl);
                LATE_STEP();
                int t2 = threadIdx.x; asm volatile("" : "+v"(t2));
                const int r32 = t2 & 31, hi = (t2 >> 5) & 1; const size_t row0 = (size_t)b * SEQ + qb * 256 + (t2 >> 6) * 32;
                scrO = (f32x4*)((float*)(ws + WS_O0) + ((size_t)bx * 512 + t2) * 64);
                float g4[4];
#pragma unroll
                for (int db = 0; db < 4; ++db) g4[db] = args.sub_gain[32 * db + r32] * post;
#pragma unroll
                for (int r = 0; r < 16; ++r) {
                    float v[4], sq = 0.f;
#pragma unroll
                    for (int db = 0; db < 4; ++db) { v[db] = ((const float*)scrO)[db * 16 + r] - lam * o[db][r] * rl[r]; sq += v[db] * v[db]; }
                    sq += __shfl_xor(sq, 1); sq += __shfl_xor(sq, 2); sq += __shfl_xor(sq, 4); sq += __shfl_xor(sq, 8); sq += __shfl_xor(sq, 16);
                    const float rs = rsqrtf(sq * (1.0f / 128.0f) + 1e-6f);
                    bf16* orow = AO + (row0 + att::crow(r, hi)) * 1024 + h * 128 + r32;
#pragma unroll
                    for (int db = 0; db < 4; ++db) orow[32 * db] = (bf16)f2bf(v[db] * rs * g4[db]);
                }
            }
        }
        while (late_have) { PRO_STORE(wvl, late_g); late_g += NGW; late_have = late_g < args.nitems; if (late_have) PRO_LOAD(wvl, late_g); }
#undef LATE_STEP
#undef PRO_FIND
#undef PRO_LOAD
#undef PRO_STORE
    }
    grid.sync();
    { pg8::Gemm g{(const bf16*)(ws + WS_DAO), (const bf16*)(ws + WS_WDOUT), MTOK, DM, DM}; pg8::StaticOrder S; S.init(MTOK, DM, G, bx);
      pg8::EpiResid E{XB, ssq + (size_t)2 * MTOK * 16, 1.0f};
      pg8::gemm_phase<pg8::EpiResid, pg8::StaticOrder, true, true>(lds, g, S, E); }
    grid.sync();
    FFN_PHASES(1, 2, 3);

    FFN_PHASES(2, 3, 4);
    { pg8::Gemm g{XB, (const bf16*)(ws + WS_WMIN), MTOK, 768, DM}; pg8::StaticOrder S; S.init(MTOK, 768, G, bx);
      pg8::rstd_table_fill<0>((LAS float*)(lds + RTAB_OFF), S, ssq + (size_t)4 * MTOK * 16, RTAB_UNITS);
      pg8::EpiMlaIn E{(bf16*)(ws + WS_MCQ), (bf16*)(ws + WS_MCKV), (bf16*)(ws + WS_MK), ssq + (size_t)7 * MTOK * 16, (const LAS float*)(lds + RTAB_OFF), cosT, sinT, 0};
      pg8::gemm_phase<pg8::EpiMlaIn, pg8::StaticOrder, true, true>(lds, g, S, E); }
    grid.sync();
    { pg8::Gemm g{(const bf16*)(ws + WS_MCQ), (const bf16*)(ws + WS_WMQ), MTOK, 1536, 384}; pg8::StaticOrder S; S.init(MTOK, 1536, G, bx);
      pg8::rstd_table_fill<1>((LAS float*)(lds + RTAB_OFF), S, ssq + (size_t)7 * MTOK * 16, RTAB_UNITS);
      pg8::EpiMlaQ E{(bf16*)(ws + WS_MQ), cosT, sinT, (const LAS float*)(lds + RTAB_OFF), C2_MLA, 0};
      pg8::gemm_phase<pg8::EpiMlaQ, pg8::StaticOrder, true, true>(lds, g, S, E); }
    { pg8::Gemm g{(const bf16*)(ws + WS_MCKV), (const bf16*)(ws + WS_WMKV), MTOK, 2048, 256}; pg8::StaticOrder S; S.init(MTOK, 2048, G, bx);
      pg8::rstd_table_fill<2>((LAS float*)(lds + RTAB_OFF), S, ssq + (size_t)7 * MTOK * 16, RTAB_UNITS);
      pg8::EpiMlaKV E{(bf16*)(ws + WS_MK), (bf16*)(ws + WS_MV), (const LAS float*)(lds + RTAB_OFF), 0};
      pg8::gemm_phase<pg8::EpiMlaKV, pg8::StaticOrder, true, true>(lds, g, S, E); }
    grid.sync();
    {
        PHASE_IDS();
        const bf16* Qm = (const bf16*)(ws + WS_MQ); const bf16* Km = (const bf16*)(ws + WS_MK); const bf16* Vm = (const bf16*)(ws + WS_MV); bf16* AO = (bf16*)(ws + WS_MAO);
        for (int rep = 0; rep < ATT_REPS; ++rep)
        for (int pi = vcu; pi < 512; pi += G) {
            const int bh = pi >> 3, s8 = pi & 7, b = bh >> 3, h = bh & 7;
            for (int half = 0; half < 2; ++half) {
                const int qb = half ? s8 : 15 - s8;
                att::f32x16 o[4]; float rl[16];
                att::attn_pass4<192>(lds, Qm + (size_t)b * SEQ * 1536 + h * 192, 1536, Km + (size_t)b * SEQ * 1536 + h * 192, 1536, Vm + (size_t)b * SEQ * 1024 + h * 128, 1024, qb * 256, o, rl);
                int t2 = threadIdx.x; asm volatile("" : "+v"(t2));
                const int r32 = t2 & 31, hi = (t2 >> 5) & 1; const size_t row0 = (size_t)b * SEQ + qb * 256 + (t2 >> 6) * 32;
#pragma unroll
                for (int r = 0; r < 16; ++r) { bf16* orow = AO + (row0 + att::crow(r, hi)) * 1024 + h * 128 + r32;
#pragma unroll
                    for (int db = 0; db < 4; ++db) orow[32 * db] = (bf16)f2bf(o[db][r] * rl[r]); }
            }
        }
    }
    grid.sync();
    { pg8::Gemm g{(const bf16*)(ws + WS_MAO), (const bf16*)(ws + WS_WMOUT), MTOK, DM, DM}; pg8::StaticOrder S; S.init(MTOK, DM, G, bx);
      pg8::EpiResid E{XB, ssq + (size_t)5 * MTOK * 16, 1.0f};
      pg8::gemm_phase<pg8::EpiResid, pg8::StaticOrder, true, true>(lds, g, S, E); }
    grid.sync();
    if (G == 256) {
        { pg8::Gemm g{XB, (const bf16*)(ws + WS_WFFN + (size_t)3 * W_FFN), MTOK, 2 * DFF, DM}; pg8::StaticOrder S; S.init(MTOK, 2 * DFF, G, bx);
          pg8::rstd_table_fill<0>((LAS float*)(lds + RTAB_OFF), S, ssq + (size_t)5 * MTOK * 16, RTAB_UNITS);
          pg8::EpiSwiglu E{(bf16*)(ws + WS_ACT), DFF, (const LAS float*)(lds + RTAB_OFF), 0};
          pg8::gemm_phase<pg8::EpiSwiglu, pg8::StaticOrder, true, true>(lds, g, S, E); }
        grid.sync();
        { pg8::Gemm g{(const bf16*)(ws + WS_ACT), (const bf16*)(ws + WS_WFFN + (size_t)3 * W_FFN + W_GU), MTOK, DM, DFF}; pg8::StaticOrder S; S.init(MTOK, DM, G, bx);
          pg8::EpiResidFinal E{XB, ssq + (size_t)6 * MTOK * 16, X, args.final_norm, (unsigned*)(ws + WS_PCNT), (LAS float*)(lds + RTAB_OFF), 0.5f};
          pg8::gemm_phase<pg8::EpiResidFinal, pg8::StaticOrder, true, true>(lds, g, S, E); }
    } else {
    FFN_PHASES(3, 5, 6);


    PHASE_IDS();
    for (int mrow0 = gw; mrow0 < MTOK; mrow0 += 2 * NGW) {
        const bool two = mrow0 + NGW < MTOK; const int mrow1 = two ? mrow0 + NGW : mrow0;
        unsigned long long wa[4], wb[4];
#pragma unroll
        for (int j = 0; j < 4; ++j) { wa[j] = ((const unsigned long long*)(XB + (size_t)mrow0 * DM) + lane)[64 * j]; wb[j] = ((const unsigned long long*)(XB + (size_t)mrow1 * DM) + lane)[64 * j]; }
        const float ra = pg8::rstd1024(ssq + (size_t)6 * MTOK * 16, mrow0), rb = pg8::rstd1024(ssq + (size_t)6 * MTOK * 16, mrow1);
#pragma unroll
        for (int rr = 0; rr < 2; ++rr) { if (rr == 1 && !two) break; const int mrow = rr ? mrow1 : mrow0; const float r = rr ? rb : ra; f32x4* orow = (f32x4*)(X + (size_t)mrow * DM) + lane;
#pragma unroll
            for (int j = 0; j < 4; ++j) { const unsigned long long w = rr ? wb[j] : wa[j]; const unsigned w0 = (unsigned)w, w1 = (unsigned)(w >> 32); const f32x4 gn = *((const f32x4*)args.final_norm + lane + 64 * j);
                f32x4 v; v.x = __uint_as_float(w0 << 16); v.y = __uint_as_float(w0 & 0xffff0000u); v.z = __uint_as_float(w1 << 16); v.w = __uint_as_float(w1 & 0xffff0000u);
                orow[64 * j] = v * r * gn; } }
    }
    }
#undef FFN_PHASES
}

extern "C" void kernel_launch(void* const* d_in, const int* in_sizes, int n_in, void* d_out, int out_size, void* d_ws, size_t ws_size, hipStream_t stream) {
    static int grid = 0;
    if (grid == 0) {
        if (n_in != 25 || out_size != MTOK * DM || ws_size < WS_END) { fprintf(stderr, "kernel_launch: unexpected shapes (n_in %d, out %d, ws %zu)\n", n_in, out_size, ws_size); grid = -1; return; }
        int dev = 0, cus = 0, per_cu = 0;
        hipGetDevice(&dev); hipDeviceGetAttribute(&cus, hipDeviceAttributeMultiprocessorCount, dev);
        hipFuncSetAttribute((const void*)fwd_kernel, hipFuncAttributeMaxDynamicSharedMemorySize, LDS_BYTES);
        hipOccupancyMaxActiveBlocksPerMultiprocessor(&per_cu, (const void*)fwd_kernel, NWAVES * 64, LDS_BYTES);
        if (per_cu < 1) per_cu = 1;
        (void)hipGetLastError();
        grid = cus;
        fprintf(stderr, "kernel_launch: cus %d per_cu %d grid %d\n", cus, per_cu, grid);
    }
    if (grid < 0) return;
    Args a{};
    const float* const* in = (const float* const*)d_in;
    a.x = in[0]; a.pos = (const int*)d_in[1];
    a.lq1 = in[12]; a.lk1 = in[13]; a.lq2 = in[14]; a.lk2 = in[15]; a.sub_gain = in[16]; a.mq_norm = in[19]; a.mkv_norm = in[21]; a.final_norm = in[24];
    a.out = (float*)d_out; a.ws = (unsigned char*)d_ws;
    unsigned char* ws = (unsigned char*)d_ws;
    int nd = 0, items = 0;
    auto add = [&](const float* W, const float* gain, size_t wt_off, int K, int N, int mode) { WDesc& d = a.wd[nd++]; d.W = W; d.gain = gain; d.WT = (bf16*)(ws + wt_off); d.K = K; d.N = N; d.mode = mode; d.item0 = items; items += (K / 64) * (N / 32); };
    auto add_ffn = [&](int l, int f) { const int base = f ? 7 : 2; const size_t wo = WS_WFFN + (size_t)(l * 2 + f) * W_FFN; const float* gain = in[base] + (size_t)l * DM;
        add(in[base + 1] + (size_t)l * DM * DFF, gain, wo, DM, DFF, 1); add(in[base + 2] + (size_t)l * DM * DFF, gain, wo, DM, DFF, 2); add(in[base + 3] + (size_t)l * DFF * DM, nullptr, wo + W_GU, DFF, DM, 0); };
    add_ffn(0, 0);
    add(in[11], in[6], WS_WDIN, DM, 3072, 3);
    a.nearly = items;
    add(in[17], nullptr, WS_WDOUT, DM, DM, 0);
    add_ffn(0, 1); add_ffn(1, 0);
    add(in[18], in[6] + DM, WS_WMIN, DM, 704, 5);
    add(in[20], in[19], WS_WMQ, 384, 1536, 4);
    add(in[22], in[21], WS_WMKV, 256, 2048, 0);
    add(in[23], nullptr, WS_WMOUT, DM, DM, 0);
    add_ffn(1, 1);
    for (; nd < NWD; ) { WDesc& d = a.wd[nd++]; d.W = in[23]; d.gain = nullptr; d.WT = (bf16*)(ws + WS_WMOUT); d.K = 0; d.N = 32; d.mode = 0; d.item0 = 0x7fffffff; }
    a.nitems = items;
    void* kargs[] = {&a};
    hipError_t e = hipLaunchCooperativeKernel((const void*)fwd_kernel, dim3(grid), dim3(NWAVES * 64), kargs, LDS_BYTES, stream);
    if (e != hipSuccess) fprintf(stderr, "cooperative launch failed: %s (grid %d)\n", hipGetErrorString(e), grid);
}
```
